# Optimizing an MI355X kernel written in HIP

```python
import jax, jax.numpy as jnp
from jax import lax
import numpy as np

D_MODEL = 1024
BATCH = 8
SEQ = 4096
DEPTH = 1

N_META = 16
EPS = 1e-6
NEG_INF = -1e30
MLA_HEADS = 16
Q_RANK = 256
KV_RANK = 128
NOPE_DIM = 64
ROPE_DIM = 32
V_DIM = 64
ROPE_THETA = 10000.0
Q_BLOCK = 128
SSM_HEADS = 16
SSM_HEAD_DIM = 64
D_INNER = SSM_HEADS * SSM_HEAD_DIM
SSM_GROUPS = 2
HEADS_PER_GROUP = SSM_HEADS // SSM_GROUPS
D_STATE = 64
CONV_WIDTH = 4
CONV_DIM = D_INNER + 2 * SSM_GROUPS * D_STATE
CHUNK = 128
N_EXPERT_GROUPS = 4
EXPERTS_PER_GROUP = 8
N_EXPERTS = N_EXPERT_GROUPS * EXPERTS_PER_GROUP
TOP_K = 2
D_EXPERT = 256
PROJ_SIZES = (Q_RANK, KV_RANK, ROPE_DIM, D_INNER, CONV_DIM, SSM_HEADS, D_MODEL, D_MODEL)
D_IN_PROJ = Q_RANK + KV_RANK + ROPE_DIM + D_INNER + CONV_DIM + SSM_HEADS + 2 * D_MODEL

kernel_name = "hybrid_mla_ssd_gated_hmoe"


def rmsnorm(x, g):
    xf = x.astype(jnp.float32)
    y = xf * lax.rsqrt(jnp.mean(xf * xf, axis=-1, keepdims=True) + EPS)
    return (y * g.astype(jnp.float32)).astype(x.dtype)


def pad_left(a, n):
    return jnp.pad(a, [(0, 0), (n, 0)] + [(0, 0)] * (a.ndim - 2))


def apply_rope(x, cos, sin):
    x1, x2 = jnp.split(x, 2, axis=-1)
    return jnp.concatenate([x1 * cos - x2 * sin, x2 * cos + x1 * sin], axis=-1).astype(x.dtype)


def mla_branch(cq, ckv, kr, q_norm, w_uq, kv_norm, w_ukv):
    b, L, _ = cq.shape
    pad = CHUNK - N_META
    Lp = L + pad
    nb = Lp // Q_BLOCK
    q = (rmsnorm(cq, q_norm) @ w_uq).reshape(b, L, MLA_HEADS, NOPE_DIM + ROPE_DIM)
    kv = (rmsnorm(ckv, kv_norm) @ w_ukv).reshape(b, L, MLA_HEADS, NOPE_DIM + V_DIM)
    q, kv, kr = pad_left(q, pad), pad_left(kv, pad), pad_left(kr, pad)
    key_pos = jnp.arange(Lp)
    pos = jnp.maximum(key_pos - pad, 0).astype(jnp.float32)
    inv = ROPE_THETA ** (-jnp.arange(0, ROPE_DIM, 2, dtype=jnp.float32) / ROPE_DIM)
    ang = pos[:, None] * inv[None, :]
    cos, sin = jnp.cos(ang), jnp.sin(ang)
    q_nope, q_rope = q[..., :NOPE_DIM], q[..., NOPE_DIM:]
    q_rope = apply_rope(q_rope, cos[None, :, None, :], sin[None, :, None, :])
    k_nope, v = kv[..., :NOPE_DIM], kv[..., NOPE_DIM:]
    k_rope = apply_rope(kr, cos[None], sin[None])
    scale = (NOPE_DIM + ROPE_DIM) ** -0.5
    qn_b = jnp.moveaxis(q_nope.reshape(b, nb, Q_BLOCK, MLA_HEADS, NOPE_DIM), 1, 0)
    qr_b = jnp.moveaxis(q_rope.reshape(b, nb, Q_BLOCK, MLA_HEADS, ROPE_DIM), 1, 0)

    def attend(args):
        qn, qr, blk = args
        qpos = blk * Q_BLOCK + jnp.arange(Q_BLOCK)
        s = jnp.einsum('bqhd,bkhd->bhqk', qn, k_nope) + jnp.einsum('bqhr,bkr->bhqk', qr, k_rope)
        s = s.astype(jnp.float32) * scale
        mask = (key_pos[None, :] <= qpos[:, None]) & (key_pos[None, :] >= pad)
        s = jnp.where(mask, s, NEG_INF)
        p = jax.nn.softmax(s, axis=-1).astype(v.dtype)
        return jnp.einsum('bhqk,bkhd->bqhd', p, v)

    o = lax.map(attend, (qn_b, qr_b, jnp.arange(nb)))
    o = jnp.moveaxis(o, 0, 1).reshape(b, Lp, MLA_HEADS * V_DIM)
    return o[:, pad:]


def ssd_branch(z, xbc, dt_raw, conv_w, conv_b, dt_bias, a_log, d_skip, norm_g):
    b, L, _ = xbc.shape
    pad = CHUNK - N_META
    Lp = L + pad
    nc = Lp // CHUNK
    xbc = lax.conv_general_dilated(xbc, conv_w[:, None, :], window_strides=(1,),
                                   padding=[(CONV_WIDTH - 1, 0)],
                                   dimension_numbers=('NWC', 'WIO', 'NWC'),
                                   feature_group_count=CONV_DIM) + conv_b
    xbc = jax.nn.silu(xbc)
    xs = xbc[..., :D_INNER]
    bm = xbc[..., D_INNER:D_INNER + SSM_GROUPS * D_STATE]
    cm = xbc[..., D_INNER + SSM_GROUPS * D_STATE:]
    dt = jax.nn.softplus((dt_raw + dt_bias).astype(jnp.float32))
    A = -jnp.exp(a_log.astype(jnp.float32)).reshape(SSM_GROUPS, HEADS_PER_GROUP)
    xs, bm, cm, dt = pad_left(xs, pad), pad_left(bm, pad), pad_left(cm, pad), pad_left(dt, pad)
    x = xs.reshape(b, nc, CHUNK, SSM_GROUPS, HEADS_PER_GROUP, SSM_HEAD_DIM)
    bm = bm.reshape(b, nc, CHUNK, SSM_GROUPS, D_STATE)
    cm = cm.reshape(b, nc, CHUNK, SSM_GROUPS, D_STATE)
    dt = dt.reshape(b, nc, CHUNK, SSM_GROUPS, HEADS_PER_GROUP)
    a = dt * A
    xdt = x * dt[..., None]
    a_cs = jnp.cumsum(a, axis=2)
    seg = a_cs[:, :, :, None] - a_cs[:, :, None, :]
    tril = jnp.tril(jnp.ones((CHUNK, CHUNK), dtype=bool))[:, :, None, None]
    lmat = jnp.exp(jnp.where(tril, seg, -jnp.inf))
    cb = jnp.einsum('bclgn,bcsgn->bclsg', cm, bm)
    y_diag = jnp.einsum('bclsg,bclsge,bcsgep->bclgep', cb, lmat, xdt)
    decay = jnp.exp(a_cs[:, :, -1:] - a_cs)
    states = jnp.einsum('bclgn,bclge,bclgep->bcgepn', bm, decay, xdt)
    chunk_decay = jnp.exp(a_cs[:, :, -1])

    def step(carry, inp):
        st, dec = inp
        return carry * dec[..., None, None] + st, carry

    init = jnp.zeros((b, SSM_GROUPS, HEADS_PER_GROUP, SSM_HEAD_DIM, D_STATE), states.dtype)
    _, prev = lax.scan(step, init, (jnp.moveaxis(states, 1, 0), jnp.moveaxis(chunk_decay, 1, 0)))
    prev = jnp.moveaxis(prev, 0, 1)
    y_off = jnp.einsum('bclgn,bcgepn,bclge->bclgep', cm, prev, jnp.exp(a_cs))
    y = y_diag + y_off + x * d_skip.reshape(SSM_GROUPS, HEADS_PER_GROUP)[:, :, None]
    y = y.reshape(b, Lp, D_INNER)[:, pad:]
    yz = (y * jax.nn.silu(z)).astype(jnp.float32).reshape(b, L, SSM_GROUPS, D_INNER // SSM_GROUPS)
    yz = yz * lax.rsqrt(jnp.mean(yz * yz, axis=-1, keepdims=True) + EPS)
    return (yz.reshape(b, L, D_INNER) * norm_g.astype(jnp.float32)).astype(z.dtype)


def hier_moe(v, w_group, b_group, w_expert, b_expert, w_gate, w_up, w_down):
    shp = v.shape
    vt = v.reshape(-1, D_MODEL)
    g_logits = (vt @ w_group + b_group).astype(jnp.float32)
    p_group = jax.nn.softmax(g_logits, axis=-1)
    g_idx = jnp.argmax(g_logits, axis=-1)
    p_g = jnp.take_along_axis(p_group, g_idx[:, None], axis=-1)
    e_logits = (vt @ w_expert + b_expert).astype(jnp.float32).reshape(-1, N_EXPERT_GROUPS, EXPERTS_PER_GROUP)
    e_logits = jnp.take_along_axis(e_logits, g_idx[:, None, None], axis=1)[:, 0]
    top_vals, top_idx = lax.top_k(e_logits, TOP_K)
    w = jax.nn.softmax(top_vals, axis=-1) * p_g
    ids = g_idx[:, None] * EXPERTS_PER_GROUP + top_idx
    comb = jnp.sum(jax.nn.one_hot(ids, N_EXPERTS, dtype=jnp.float32) * w[..., None], axis=1).astype(vt.dtype)
    out = jnp.zeros_like(vt)
    for gi in range(N_EXPERT_GROUPS):
        sl = slice(gi * EXPERTS_PER_GROUP, (gi + 1) * EXPERTS_PER_GROUP)
        h = jax.nn.silu(jnp.einsum('td,edf->tef', vt, w_gate[sl])) * jnp.einsum('td,edf->tef', vt, w_up[sl])
        out = out + jnp.einsum('tef,te,efd->td', h, comb[:, sl], w_down[sl])
    return out.reshape(shp)


def setup_inputs(seed: int = 0) -> dict:
    key = jax.random.key(seed)
    ks = jax.random.split(key, 32)

    def nrm(k, shape, scale):
        return jax.random.normal(k, shape, jnp.float32) * scale

    def gain(k, shape):
        return 1.0 + 0.01 * jax.random.normal(k, shape, jnp.float32)

    dt0 = jnp.exp(jax.random.uniform(ks[9], (DEPTH, SSM_HEADS), jnp.float32, np.log(1e-3), np.log(1e-1)))
    return {
        "x": nrm(ks[0], (BATCH, SEQ, D_MODEL), 1.0),
        "meta_tokens": nrm(ks[1], (N_META, D_MODEL), 1.0),
        "norm_mix": gain(ks[2], (DEPTH, D_MODEL)),
        "w_in": nrm(ks[3], (DEPTH, D_MODEL, D_IN_PROJ), D_MODEL ** -0.5),
        "mla_q_norm": gain(ks[4], (DEPTH, Q_RANK)),
        "mla_w_uq": nrm(ks[5], (DEPTH, Q_RANK, MLA_HEADS * (NOPE_DIM + ROPE_DIM)), Q_RANK ** -0.5),
        "mla_kv_norm": gain(ks[6], (DEPTH, KV_RANK)),
        "mla_w_ukv": nrm(ks[7], (DEPTH, KV_RANK, MLA_HEADS * (NOPE_DIM + V_DIM)), KV_RANK ** -0.5),
        "ssm_conv_w": nrm(ks[8], (DEPTH, CONV_WIDTH, CONV_DIM), CONV_WIDTH ** -0.5),
        "ssm_conv_b": nrm(ks[10], (DEPTH, CONV_DIM), 0.01),
        "ssm_dt_bias": dt0 + jnp.log(-jnp.expm1(-dt0)),
        "ssm_a_log": jnp.log(jax.random.uniform(ks[11], (DEPTH, SSM_HEADS), jnp.float32, 1.0, 16.0)),
        "ssm_d_skip": gain(ks[12], (DEPTH, SSM_HEADS)),
        "ssm_norm": gain(ks[13], (DEPTH, D_INNER)),
        "w_branch_attn": nrm(ks[14], (DEPTH, MLA_HEADS * V_DIM, D_MODEL), (MLA_HEADS * V_DIM) ** -0.5),
        "w_branch_ssm": nrm(ks[15], (DEPTH, D_INNER, D_MODEL), D_INNER ** -0.5),
        "w_out": nrm(ks[16], (DEPTH, D_MODEL, D_MODEL), D_MODEL ** -0.5),
        "norm_ffn": gain(ks[17], (DEPTH, D_MODEL)),
        "moe_w_group": nrm(ks[18], (DEPTH, D_MODEL, N_EXPERT_GROUPS), D_MODEL ** -0.5),
        "moe_b_group": nrm(ks[19], (DEPTH, N_EXPERT_GROUPS), 0.01),
        "moe_w_expert": nrm(ks[20], (DEPTH, D_MODEL, N_EXPERTS), D_MODEL ** -0.5),
        "moe_b_expert": nrm(ks[21], (DEPTH, N_EXPERTS), 0.01),
        "moe_w_gate": nrm(ks[22], (DEPTH, N_EXPERTS, D_MODEL, D_EXPERT), D_MODEL ** -0.5),
        "moe_w_up": nrm(ks[23], (DEPTH, N_EXPERTS, D_MODEL, D_EXPERT), D_MODEL ** -0.5),
        "moe_w_down": nrm(ks[24], (DEPTH, N_EXPERTS, D_EXPERT, D_MODEL), D_EXPERT ** -0.5),
        "norm_final": gain(ks[25], (D_MODEL,)),
    }


def reference(x, meta_tokens, norm_mix, w_in, mla_q_norm, mla_w_uq, mla_kv_norm, mla_w_ukv,
              ssm_conv_w, ssm_conv_b, ssm_dt_bias, ssm_a_log, ssm_d_skip, ssm_norm,
              w_branch_attn, w_branch_ssm, w_out, norm_ffn, moe_w_group, moe_b_group,
              moe_w_expert, moe_b_expert, moe_w_gate, moe_w_up, moe_w_down, norm_final):
    b = x.shape[0]
    meta = jnp.broadcast_to(meta_tokens.astype(x.dtype)[None], (b, N_META, D_MODEL))
    h = jnp.concatenate([meta, x], axis=1)
    split_idx = list(np.cumsum(PROJ_SIZES)[:-1])
    for l in range(DEPTH):
        u = rmsnorm(h, norm_mix[l])
        proj = u @ w_in[l]
        cq, ckv, kr, z, xbc, dt_raw, g_attn, g_ssm = jnp.split(proj, split_idx, axis=-1)
        o_attn = mla_branch(cq, ckv, kr, mla_q_norm[l], mla_w_uq[l], mla_kv_norm[l], mla_w_ukv[l])
        o_ssm = ssd_branch(z, xbc, dt_raw, ssm_conv_w[l], ssm_conv_b[l], ssm_dt_bias[l],
                           ssm_a_log[l], ssm_d_skip[l], ssm_norm[l])
        merged = (jax.nn.sigmoid(g_attn) * (o_attn @ w_branch_attn[l])
                  + jax.nn.sigmoid(g_ssm) * (o_ssm @ w_branch_ssm[l]))
        h = h + (merged @ w_out[l]).astype(h.dtype)
        h = h + hier_moe(rmsnorm(h, norm_ffn[l]), moe_w_group[l], moe_b_group[l], moe_w_expert[l],
                         moe_b_expert[l], moe_w_gate[l], moe_w_up[l], moe_w_down[l]).astype(h.dtype)
    return rmsnorm(h, norm_final)[:, N_META:]
```

```cpp
#include <hip/hip_runtime.h>
#include <cstdio>
#include <cstdint>
namespace pg8 {
#define PG8_LAS __attribute__((address_space(3)))
typedef unsigned short bf16_t;
typedef short bf16x8 __attribute__((ext_vector_type(8)));
typedef float f32x4 __attribute__((ext_vector_type(4)));
typedef unsigned u32x4 __attribute__((ext_vector_type(4)));
constexpr int BM = 256, BK = 64, HALF = 128, HTB = HALF * BK * 2  , STAGE_BYTES = 8 * HTB, NXCD = 8, WGM = 8;

__host__ __device__ __forceinline__ int lds_byte(int r, int c) { const int st = (r >> 4) * 2 + (c >> 5), rr = r & 15, cc = c & 31, ob = rr * 64 + cc * 2; return st * 1024 + (ob ^ (((ob >> 9) & 1) << 5)); }
__host__ __device__ __forceinline__ void stage_rc(int b, int& R, int& C) { const int st = b / 1024, sb = b % 1024, swz = sb ^ (((sb >> 9) & 1) << 5); R = (st >> 1) * 16 + swz / 64; C = (st & 1) * 32 + (swz % 64) / 2; }
__host__ __device__ __forceinline__ int perm32(int rho) { const int n = rho >> 4, i = rho & 15; return 8 * (i >> 2) + 4 * n + (i & 3); }

struct Unit { int pm, pn; };
struct Gemm { const bf16_t* A; const bf16_t* Bt; int M, N, K; };

struct StaticOrder {
    int nM, nN, nwg, G, c;
    __host__ __device__ void init(int M, int N, int G_, int c_) { nM = M / BM; nN = N / BM; nwg = nM * nN; G = G_; c = c_; }
    __host__ __device__ bool next(int i, Unit& u) const {
        const long L = (long)i * G + c; if (L >= nwg) return false;
        int wgid = (int)L; { const int q = nwg / NXCD, r = nwg % NXCD, xcd = wgid % NXCD, off = wgid / NXCD; wgid = (xcd < r ? xcd * (q + 1) : r * (q + 1) + (xcd - r) * q) + off; }
        const int nig = WGM * nN, gid = wgid / nig, fm = gid * WGM, gsz = (nM - fm) < WGM ? (nM - fm) : WGM;
        u.pm = fm + ((wgid % nig) % gsz); u.pn = (wgid % nig) / gsz; return true;
    }
    __device__ __forceinline__ void a_ready(const Unit&) const {}
    __device__ __forceinline__ void done(const Unit&) const {}
};

__device__ __forceinline__ unsigned cvt_pk_bf16(float lo, float hi) { unsigned r; asm volatile("v_cvt_pk_bf16_f32 %0, %1, %2" : "=v"(r) : "v"(lo), "v"(hi)); return r; }
template <class Epi, class Sched, bool ALIGN_EPI = false, bool SP2 = false>
__device__ __forceinline__ void gemm_phase(PG8_LAS unsigned char* lds, const Gemm g, const Sched& S, const Epi& E) {
    const int tid = threadIdx.x, wid = __builtin_amdgcn_readfirstlane(tid >> 6), lane = tid & 63, wr = wid >> 2, wc = wid & 3, fr = lane & 15, fq = lane >> 4;
    const int K = g.K, nt = K / BK;
    unsigned voffA[2], voffB[2];
#pragma unroll
    for (int i = 0; i < 2; ++i) { int R, C; stage_rc(tid * 16 + i * 8192, R, C); const int Rb = Epi::PERM ? ((R & ~31) + perm32(R & 31)) : R;
        voffA[i] = (unsigned)(R * K + C) * 2u; voffB[i] = (unsigned)(Rb * K + C) * 2u; }
    const size_t kstep = (size_t)(BK * 2);
    const size_t hstep = (size_t)HALF * K * 2;
    const size_t tstep = 2 * hstep;
    const unsigned ldsw = (unsigned)wid * 1024u;
    const int aoff = lds_byte(wr * 64 + fr, fq * 8), boff = lds_byte(wc * 32 + fr, fq * 8);
#define PG8_SA(b, h) (((b) * 2 + (h)) * HTB)
#define PG8_SB(b, h) ((4 + (b) * 2 + (h)) * HTB)
#define PG8_STAGE(bufoff, gbase, voff) do { _Pragma("unroll") for (int _i = 0; _i < 2; ++_i) \
        __builtin_amdgcn_global_load_lds((const unsigned*)((const char*)(gbase) + (voff)[_i]), (PG8_LAS unsigned*)(lds + (bufoff) + ldsw + _i * 8192), 16, 0, 0); } while (0)
#define PG8_LDA(dst, b, h) do { _Pragma("unroll") for (int m = 0; m < 4; ++m) _Pragma("unroll") for (int k = 0; k < 2; ++k) dst[m][k] = *(const PG8_LAS bf16x8*)(lds + PG8_SA(b, h) + aoff + m * 2048 + k * 1024); } while (0)
#define PG8_LDB(dst, b, h) do { _Pragma("unroll") for (int n = 0; n < 2; ++n) _Pragma("unroll") for (int k = 0; k < 2; ++k) dst[n][k] = *(const PG8_LAS bf16x8*)(lds + PG8_SB(b, h) + boff + n * 2048 + k * 1024); } while (0)
#define PG8_MMA(ai, bj, At, Bt) do { __builtin_amdgcn_s_setprio(1); _Pragma("unroll") for (int m = 0; m < 4; ++m) _Pragma("unroll") for (int n = 0; n < 2; ++n) _Pragma("unroll") for (int k = 0; k < 2; ++k) \
        acc[ai][bj][m][n] = __builtin_amdgcn_mfma_f32_16x16x32_bf16(Bt[n][k], At[m][k], acc[ai][bj][m][n], 0, 0, 0); __builtin_amdgcn_s_setprio(0); } while (0)
#define PG8_WAIT_V(n) asm volatile("s_waitcnt vmcnt(" #n ")" ::: "memory")
#define PG8_WAIT_L(n) asm volatile("s_waitcnt lgkmcnt(" #n ")" ::: "memory")
#define PG8_BAR __builtin_amdgcn_s_barrier()
#define PG8_SCHED __builtin_amdgcn_sched_barrier(0)
    Unit cur, nxt; int ui = 0;
    if (!S.next(0, cur)) return;
    f32x4 acc[2][2][4][2];
#pragma unroll
    for (int a = 0; a < 2; ++a)
#pragma unroll
        for (int b = 0; b < 2; ++b)
#pragma unroll
            for (int m = 0; m < 4; ++m)
#pragma unroll
                for (int n = 0; n < 2; ++n) acc[a][b][m][n] = (f32x4){0.f, 0.f, 0.f, 0.f};
    bf16x8 At[4][2], B0[2][2], B1[2][2];
    const char* cA = (const char*)g.A + (size_t)cur.pm * tstep; const char* cB = (const char*)g.Bt + (size_t)cur.pn * tstep;
    S.a_ready(cur);
    if constexpr (SP2) {
        PG8_STAGE(PG8_SB(0, 0), cB, voffB); PG8_STAGE(PG8_SB(0, 1), cB + hstep, voffB); PG8_STAGE(PG8_SA(0, 0), cA, voffA); PG8_STAGE(PG8_SA(0, 1), cA + hstep, voffA);
        if (wr == 1) PG8_BAR;
        PG8_WAIT_V(2); PG8_BAR;
        PG8_STAGE(PG8_SB(1, 0), cB + kstep, voffB); PG8_STAGE(PG8_SA(1, 0), cA + kstep, voffA); PG8_STAGE(PG8_SB(1, 1), cB + hstep + kstep, voffB);
        PG8_WAIT_V(6); PG8_BAR;
    } else {
        PG8_STAGE(PG8_SB(0, 0), cB, voffB); PG8_STAGE(PG8_SA(0, 0), cA, voffA); PG8_STAGE(PG8_SB(0, 1), cB + hstep, voffB); PG8_STAGE(PG8_SA(0, 1), cA + hstep, voffA);
        if (wr == 1) PG8_BAR;
        PG8_WAIT_V(4); PG8_BAR;
        PG8_STAGE(PG8_SB(1, 0), cB + kstep, voffB); PG8_STAGE(PG8_SA(1, 0), cA + kstep, voffA); PG8_STAGE(PG8_SB(1, 1), cB + hstep + kstep, voffB);
        PG8_WAIT_V(6); PG8_BAR;
    }
    for (;;) {
        const bool has_next = S.next(ui + 1, nxt);
        const char* nA = has_next ? (const char*)g.A + (size_t)nxt.pm * tstep : cA; const char* nB = has_next ? (const char*)g.Bt + (size_t)nxt.pn * tstep : cB;
        for (int t = 0; t < nt; t += 2) {
            const bool last = (t == nt - 2);
            const char* a1 = cA + (size_t)(t + 1) * kstep;
            const char* a2 = last ? nA : cA + (size_t)(t + 2) * kstep; const char* b2 = last ? nB : cB + (size_t)(t + 2) * kstep;
            const char* a3 = a2 + kstep; const char* b3 = b2 + kstep;
            if (last && has_next) S.a_ready(nxt);
            if constexpr (SP2) {
            PG8_LDB(B0, 0, 0); PG8_LDB(B1, 0, 1); PG8_SCHED; PG8_LDA(At, 0, 0); PG8_STAGE(PG8_SA(1, 1), a1 + hstep, voffA);
            PG8_WAIT_V(8); PG8_WAIT_L(0); PG8_BAR; PG8_MMA(0, 0, At, B0); PG8_MMA(0, 1, At, B1); PG8_BAR; PG8_SCHED;
            PG8_LDA(At, 0, 1); PG8_STAGE(PG8_SB(0, 0), b2, voffB); PG8_STAGE(PG8_SB(0, 1), b2 + hstep, voffB); PG8_STAGE(PG8_SA(0, 0), a2, voffA);
            PG8_WAIT_V(8); PG8_WAIT_L(0); PG8_BAR; PG8_MMA(1, 0, At, B0); PG8_MMA(1, 1, At, B1); PG8_BAR; PG8_SCHED;
            PG8_LDB(B0, 1, 0); PG8_LDB(B1, 1, 1); PG8_SCHED; PG8_LDA(At, 1, 0); PG8_STAGE(PG8_SA(0, 1), a2 + hstep, voffA);
            PG8_WAIT_V(8); PG8_WAIT_L(0); PG8_BAR; PG8_MMA(0, 0, At, B0); PG8_MMA(0, 1, At, B1); PG8_BAR; PG8_SCHED;
            PG8_LDA(At, 1, 1); PG8_STAGE(PG8_SB(1, 0), b3, voffB); PG8_STAGE(PG8_SB(1, 1), b3 + hstep, voffB); PG8_STAGE(PG8_SA(1, 0), a3, voffA);
            PG8_WAIT_V(8); PG8_WAIT_L(0); PG8_BAR; PG8_MMA(1, 0, At, B0); PG8_MMA(1, 1, At, B1); PG8_BAR; PG8_SCHED;
            } else {
            PG8_LDB(B0, 0, 0); PG8_SCHED; PG8_LDA(At, 0, 0); PG8_STAGE(PG8_SA(1, 1), a1 + hstep, voffA);
            PG8_WAIT_L(8); PG8_BAR; PG8_WAIT_L(0); PG8_MMA(0, 0, At, B0); PG8_BAR; PG8_SCHED;
            PG8_LDB(B1, 0, 1); PG8_STAGE(PG8_SB(0, 0), b2, voffB);
            PG8_BAR; PG8_WAIT_L(0); PG8_MMA(0, 1, At, B1); PG8_BAR;
            PG8_LDA(At, 0, 1); PG8_STAGE(PG8_SA(0, 0), a2, voffA);
            PG8_BAR; PG8_WAIT_L(0); PG8_MMA(1, 0, At, B0); PG8_BAR; PG8_SCHED;
            PG8_STAGE(PG8_SB(0, 1), b2 + hstep, voffB);
            PG8_WAIT_V(6); PG8_BAR; PG8_MMA(1, 1, At, B1); PG8_BAR;
            PG8_LDB(B0, 1, 0); PG8_SCHED; PG8_LDA(At, 1, 0); PG8_STAGE(PG8_SA(0, 1), a2 + hstep, voffA);
            PG8_WAIT_L(8); PG8_BAR; PG8_WAIT_L(0); PG8_MMA(0, 0, At, B0); PG8_BAR; PG8_SCHED;
            PG8_LDB(B1, 1, 1); PG8_STAGE(PG8_SB(1, 0), b3, voffB);
            PG8_BAR; PG8_WAIT_L(0); PG8_MMA(0, 1, At, B1); PG8_BAR;
            PG8_LDA(At, 1, 1); PG8_STAGE(PG8_SA(1, 0), a3, voffA);
            PG8_BAR; PG8_WAIT_L(0); PG8_MMA(1, 0, At, B0); PG8_BAR; PG8_SCHED;
            PG8_STAGE(PG8_SB(1, 1), b3 + hstep, voffB);
            PG8_WAIT_V(6); PG8_BAR; PG8_MMA(1, 1, At, B1); PG8_BAR;
            }
        }
        if constexpr (ALIGN_EPI) { if (wr == 0) PG8_BAR; }
        if constexpr (!Epi::AFTER_DRAIN) { E(acc, cur, wr, wc, fr, fq); S.done(cur); }
        if (!has_next) break;
#pragma unroll
        for (int a = 0; a < 2; ++a)
#pragma unroll
            for (int b = 0; b < 2; ++b)
#pragma unroll
                for (int m = 0; m < 4; ++m)
#pragma unroll
                    for (int n = 0; n < 2; ++n) acc[a][b][m][n] = (f32x4){0.f, 0.f, 0.f, 0.f};
        cur = nxt; cA = nA; cB = nB; ++ui;
        if constexpr (ALIGN_EPI) { if (wr == 1) PG8_BAR; }
    }
    PG8_WAIT_V(0);
    if constexpr (!ALIGN_EPI) { if (wr == 0) PG8_BAR; }
    PG8_BAR;
    if constexpr (Epi::AFTER_DRAIN) { E.fused(acc, cur, wr, wc, fr, fq, lds, wid, lane); S.done(cur); }
#undef PG8_SA
#undef PG8_SB
#undef PG8_STAGE
#undef PG8_LDA
#undef PG8_LDB
#undef PG8_MMA
#undef PG8_WAIT_V
#undef PG8_WAIT_L
#undef PG8_BAR
#undef PG8_SCHED
}
}
#define GAS __attribute__((address_space(1)))
#define LAS __attribute__((address_space(3)))
typedef unsigned short bf16;
typedef unsigned v4u __attribute__((ext_vector_type(4)));
typedef float f32x4 __attribute__((ext_vector_type(4)));
typedef short bf16x8 __attribute__((ext_vector_type(8)));
typedef GAS unsigned gu32;
typedef GAS unsigned long long gu64;
#define RLX_AGENT __ATOMIC_RELAXED, __HIP_MEMORY_SCOPE_AGENT
#define LDS_WAIT() asm volatile("s_waitcnt lgkmcnt(0)" ::: "memory")
#define VM_WAIT() asm volatile("s_waitcnt vmcnt(0)" ::: "memory")
__device__ __forceinline__ unsigned long long rt() { return __builtin_amdgcn_s_memrealtime(); }
__device__ __forceinline__ unsigned f2bf(float f) { unsigned u = __builtin_bit_cast(unsigned, f); return (u + 0x7fffu + ((u >> 16) & 1u)) >> 16; }
__device__ __forceinline__ unsigned pk2(float lo, float hi) { return f2bf(lo) | (f2bf(hi) << 16); }
#define XB_TMO      128
#define XB_XCNT(j)  (256  + 64 * (j))
#define XB_XSUB(j)  (1280 + 64 * (j))
#define XB_XGEN(j)  (2304 + 64 * (j))
#define XB_TOP      3328
#define XB_TOPGEN   3392
#define XCD_BAR_WORDS 3456
#define XB_SPIN_CAP (1u << 18)

__device__ __forceinline__ unsigned xb_ld(unsigned* p)              { return __hip_atomic_load(p, __ATOMIC_RELAXED, __HIP_MEMORY_SCOPE_AGENT); }
__device__ __forceinline__ unsigned xb_add(unsigned* p, unsigned v) { return __hip_atomic_fetch_add(p, v, __ATOMIC_RELAXED, __HIP_MEMORY_SCOPE_AGENT); }
__device__ __forceinline__ unsigned xb_xcc_id() { return (unsigned)__builtin_amdgcn_s_getreg((3 << 11) | 20) & 0xFu; }
#define XB_SPIN(cond, bar) do { unsigned _sp = 0; while (cond) { __builtin_amdgcn_s_sleep(1); \
    if ((++_sp & 255u) == 0u) { if (xb_ld(&(bar)[XB_TMO])) break; if (_sp > XB_SPIN_CAP) { atomicAdd(&(bar)[XB_TMO], 1u); break; } } } } while (0)

struct XcdBarrier {
    unsigned* bar; unsigned x;
    volatile LAS unsigned* st;
};

__device__ __forceinline__ XcdBarrier xcd_barrier_post(unsigned* bar, volatile LAS unsigned* st) {
    XcdBarrier b; b.bar = bar; b.x = xb_xcc_id(); b.st = st;
    if (threadIdx.x == 0) (void)xb_add(&bar[XB_XCNT(b.x)], 1u);
    return b;
}
__device__ __forceinline__ void xcd_barrier_complete(unsigned* bar, unsigned x, unsigned& nloc, unsigned& nx) {
    const unsigned G = gridDim.x * gridDim.y * gridDim.z;
    unsigned sum, cnt, mine, sp = 0u;
    for (;;) {
        sum = 0u; cnt = 0u; mine = 0u;
#pragma unroll
        for (unsigned j = 0; j < 16; ++j) { const unsigned c = xb_ld(&bar[XB_XCNT(j)]); sum += c; cnt += (c > 0u) ? 1u : 0u; mine = (j == x) ? c : mine; }
        if (sum == G) break;
        __builtin_amdgcn_s_sleep(1);
        if ((++sp & 255u) == 0u) { if (xb_ld(&bar[XB_TMO])) break; if (sp > XB_SPIN_CAP) { atomicAdd(&bar[XB_TMO], 1u); break; } }
    }
    nloc = mine > 0u ? mine : 1u; nx = cnt > 0u ? cnt : 1u;
}

__device__ __forceinline__ void xcd_barrier(const XcdBarrier& b) {
    asm volatile("s_waitcnt vmcnt(0)" ::: "memory");
    __syncthreads();
    if (threadIdx.x == 0) {
        unsigned* bar = b.bar;
        __builtin_amdgcn_s_waitcnt(0);
        unsigned nloc = b.st[0], nx = b.st[1];
        if (nloc == 0u) { xcd_barrier_complete(bar, b.x, nloc, nx); b.st[0] = nloc; b.st[1] = nx; }
        const unsigned old = xb_add(&bar[XB_XSUB(b.x)], 1u);
        const unsigned gen = old / nloc;
        if (old + 1u == (gen + 1u) * nloc) {
            __builtin_amdgcn_fence(__ATOMIC_RELEASE, "agent");
            asm volatile("s_waitcnt vmcnt(0)" ::: "memory");
            const unsigned og = xb_add(&bar[XB_TOP], 1u);
            const unsigned tg = og / nx;
            if (og + 1u == (tg + 1u) * nx) xb_add(&bar[XB_TOPGEN], 1u);
            else XB_SPIN(xb_ld(&bar[XB_TOPGEN]) == tg, bar);
            __builtin_amdgcn_fence(__ATOMIC_ACQUIRE, "agent");
            xb_add(&bar[XB_XGEN(b.x)], 1u);
            asm volatile("s_waitcnt vmcnt(0)" ::: "memory");
        } else {
            XB_SPIN(xb_ld(&bar[XB_XGEN(b.x)]) == gen, bar);
            __builtin_amdgcn_fence(__ATOMIC_ACQUIRE, "agent");
            asm volatile("s_waitcnt vmcnt(0)" ::: "memory");
        }
    }
    __syncthreads();
}

constexpr int DM = 1024, NB = 8, SEQ = 4096, NMETA = 16, LTOK = SEQ + NMETA, PADF = 112, LP = LTOK + PADF, MROWS = NB * LP;
constexpr int NHEAD = 16, CONVD = 1280, NCHUNK = LP / 128;
constexpr int NEXP = 32, TCAP = NB * LTOK;
constexpr int VPROWS = 74240;
constexpr float EPS = 1e-6f;
constexpr float QSCALE = 0.10206207261596575f * 1.4426950408889634f;
static_assert(LP % 128 == 0 && MROWS % 256 == 0, "row geometry");

constexpr size_t MiB = 1u << 20;
constexpr size_t WS_CTL = 0, CTL_ZERO_BYTES = 1 * MiB;
constexpr size_t WS_WINA = 1 * MiB, WS_WINB = WS_WINA + 3584 * 1024, WS_WUQ = WS_WINB + 6 * MiB, WS_WUKV = WS_WUQ + 768 * 1024, WS_WBA = 12 * MiB, WS_WBS = 14 * MiB, WS_WOUT = 16 * MiB,
                 WS_WGU = 18 * MiB, WS_WD = 50 * MiB, WS_CS = 66 * MiB;
constexpr size_t WS_XN = 68 * MiB;
constexpr size_t WS_KV = 134 * MiB;
constexpr size_t WS_SA = WS_KV, WS_SS = WS_KV + 66 * MiB, WS_H1 = WS_KV;
constexpr size_t WS_XBC = 266 * MiB;
constexpr size_t WS_MRG = WS_XBC;
constexpr size_t WS_Y = 349 * MiB;
constexpr size_t WS_CQ = 415 * MiB, WS_CKV = 432 * MiB, WS_KR = 441 * MiB, WS_DT = 444 * MiB, WS_SSQ = 447 * MiB, WS_SSKV = 448 * MiB, WS_KRF = 462 * MiB;
constexpr size_t WS_VP = 266 * MiB;
constexpr size_t WS_YP = WS_VP;
constexpr size_t WS_HM = 415 * MiB;
constexpr size_t WS_TOKW = 452 * MiB, WS_LIST = 453 * MiB, WS_PROW = 458 * MiB, WS_END = 460 * MiB;
static_assert(WS_WUKV + 2048 * 128 * 2 <= WS_WBA && WS_VP + (size_t)VPROWS * 2048 <= WS_HM && WS_HM + (size_t)VPROWS * 512 <= WS_TOKW && WS_LIST + (size_t)NEXP * TCAP * 4 <= WS_PROW, "ws map");

constexpr int CW_TMO = 0, CW_Q3 = 64, CW_CNT = 128, CW_BAR = 4096;

constexpr int RING_BYTES = 143360, MISC_OFF = RING_BYTES, LDS_BYTES = 147456;

typedef unsigned u32x2 __attribute__((ext_vector_type(2)));
__device__ __forceinline__ float bf2f(unsigned short b) { return __uint_as_float((unsigned)b << 16); }
__device__ __forceinline__ float bflo(unsigned u) { return __uint_as_float(u << 16); }
__device__ __forceinline__ float bfhi(unsigned u) { return __uint_as_float(u & 0xffff0000u); }
__device__ __forceinline__ float sigm(float x) { return 1.f / (1.f + __expf(-x)); }
__device__ __forceinline__ float silu(float x) { return x / (1.f + __expf(-x)); }
__device__ __forceinline__ float wave_sum(float v) {
#pragma unroll
    for (int o = 1; o < 64; o <<= 1) v += __shfl_xor(v, o);
    return v;
}
__device__ __forceinline__ void st_bf4(bf16* p, f32x4 v) { u32x2 w; w.x = pk2(v[0], v[1]); w.y = pk2(v[2], v[3]); *(u32x2*)p = w; }
__device__ __forceinline__ f32x4 ld_bf4(const bf16* p) { const u32x2 w = *(const u32x2*)p; return (f32x4){bflo(w.x), bfhi(w.x), bflo(w.y), bfhi(w.y)}; }
__device__ __forceinline__ int row_tok(int row, int& b) { b = (int)(((float)row + 0.5f) * (1.0f / (float)LP)); return row - b * LP - PADF; }

using pg8::Unit;
#define EPI_ROWS(ai, m) (u.pm * 256 + (ai) * 128 + wr * 64 + (m) * 16 + fr)
#define EPI_CL(bj, n) ((bj) * 128 + wc * 32 + (n) * 16 + fq * 4)

struct EpiInA {
    static constexpr bool PERM = false, AFTER_DRAIN = false;
    bf16 *CQ, *CKV, *XBC; float *KRF, *DT, *SSQ, *SSKV;
    __device__ __forceinline__ void operator()(const f32x4 (&acc)[2][2][4][2], const Unit& u, int wr, int wc, int fr_, int fq_) const {
        int ln_ = (int)__builtin_amdgcn_mbcnt_hi(~0u, __builtin_amdgcn_mbcnt_lo(~0u, 0u)); asm volatile("" : "+v"(ln_)); const int fr = ln_ & 15, fq = ln_ >> 4; (void)fr_; (void)fq_;
        const int pn = u.pn;
        if (pn == 0) {
#pragma unroll
            for (int ai = 0; ai < 2; ++ai)
#pragma unroll
                for (int m = 0; m < 4; ++m) { const int row = EPI_ROWS(ai, m); float s = 0.f;
#pragma unroll
                    for (int bj = 0; bj < 2; ++bj)
#pragma unroll
                        for (int n = 0; n < 2; ++n) { const f32x4 v = acc[ai][bj][m][n]; st_bf4(CQ + (size_t)row * 256 + EPI_CL(bj, n), v); s += (v[0] * v[0] + v[1] * v[1]) + (v[2] * v[2] + v[3] * v[3]); }
                    s += __shfl_xor(s, 16); s += __shfl_xor(s, 32);
                    if (fq == 0) SSQ[(size_t)row * 4 + wc] = s; asm volatile("" ::: "memory"); }
        } else if (pn == 1) {
#pragma unroll
            for (int ai = 0; ai < 2; ++ai)
#pragma unroll
                for (int m = 0; m < 4; ++m) { const int row = EPI_ROWS(ai, m); float s = 0.f;
#pragma unroll
                    for (int n = 0; n < 2; ++n) { const f32x4 v = acc[ai][0][m][n]; st_bf4(CKV + (size_t)row * 128 + wc * 32 + n * 16 + fq * 4, v); s += (v[0] * v[0] + v[1] * v[1]) + (v[2] * v[2] + v[3] * v[3]); }
                    s += __shfl_xor(s, 16); s += __shfl_xor(s, 32);
                    if (fq == 0) SSKV[(size_t)row * 4 + wc] = s;
                    if (wc == 0) { *(f32x4*)(KRF + (size_t)row * 32 + 4 * fq) = acc[ai][1][m][0]; *(f32x4*)(KRF + (size_t)row * 32 + 16 + 4 * fq) = acc[ai][1][m][1]; }
                    else if (wc == 1) *(f32x4*)(DT + (size_t)row * 16 + 4 * fq) = acc[ai][1][m][0];
                    asm volatile("" ::: "memory"); }
        } else {
            const int cb = (pn - 2) * 256;
#pragma unroll
            for (int ai = 0; ai < 2; ++ai)
#pragma unroll
                for (int m = 0; m < 4; ++m) { const int row = EPI_ROWS(ai, m);
#pragma unroll
                    for (int bj = 0; bj < 2; ++bj)
#pragma unroll
                        for (int n = 0; n < 2; ++n) st_bf4(XBC + (size_t)row * CONVD + cb + EPI_CL(bj, n), acc[ai][bj][m][n]); }
        }
    }
};

struct EpiQ {
    static constexpr bool PERM = false, AFTER_DRAIN = false;
    bf16 *Qn, *Qr; const float *SSQ, *CS;
    __device__ __forceinline__ void operator()(const f32x4 (&acc)[2][2][4][2], const Unit& u, int wr, int wc, int fr_, int fq_) const {
        int ln_ = (int)__builtin_amdgcn_mbcnt_hi(~0u, __builtin_amdgcn_mbcnt_lo(~0u, 0u)); asm volatile("" : "+v"(ln_)); const int fr = ln_ & 15, fq = ln_ >> 4; (void)fr_; (void)fq_;
        const int pn = u.pn;
#pragma unroll
        for (int ai = 0; ai < 2; ++ai)
#pragma unroll
            for (int m = 0; m < 4; ++m) { const int row = EPI_ROWS(ai, m);
                const f32x4 p = *(const f32x4*)(SSQ + (size_t)row * 4); const float rs = rsqrtf(((p[0] + p[1]) + (p[2] + p[3])) * (1.f / 256.f) + EPS);
                if (pn < 4) {
#pragma unroll
                    for (int bj = 0; bj < 2; ++bj)
#pragma unroll
                        for (int n = 0; n < 2; ++n) st_bf4(Qn + (size_t)row * 1024 + pn * 256 + EPI_CL(bj, n), acc[ai][bj][m][n] * rs);
                } else {
                    int b; const int tok = row_tok(row, b);
                    f32x4 c = (f32x4){0.f, 0.f, 0.f, 0.f}, sn = c;
                    if (tok >= 0) { c = *(const f32x4*)(CS + (size_t)tok * 32 + 4 * fq); sn = *(const f32x4*)(CS + (size_t)tok * 32 + 16 + 4 * fq); }
#pragma unroll
                    for (int bj = 0; bj < 2; ++bj) { const f32x4 x1 = acc[ai][bj][m][0] * rs, x2 = acc[ai][bj][m][1] * rs;
                        bf16* q = Qr + (size_t)row * 512 + (pn - 4) * 256 + bj * 128 + wc * 32 + 4 * fq;
                        st_bf4(q, x1 * c - x2 * sn); st_bf4(q + 16, x2 * c + x1 * sn); }
                } asm volatile("" ::: "memory"); }
    }
};
struct EpiKV {
    static constexpr bool PERM = false, AFTER_DRAIN = false;
    bf16* KV; const float* SSKV;
    __device__ __forceinline__ void operator()(const f32x4 (&acc)[2][2][4][2], const Unit& u, int wr, int wc, int fr_, int fq_) const {
        int ln_ = (int)__builtin_amdgcn_mbcnt_hi(~0u, __builtin_amdgcn_mbcnt_lo(~0u, 0u)); asm volatile("" : "+v"(ln_)); const int fr = ln_ & 15, fq = ln_ >> 4; (void)fr_; (void)fq_;
#pragma unroll
        for (int ai = 0; ai < 2; ++ai)
#pragma unroll
            for (int m = 0; m < 4; ++m) { const int row = EPI_ROWS(ai, m);
                const f32x4 p = *(const f32x4*)(SSKV + (size_t)row * 4); const float rs = rsqrtf(((p[0] + p[1]) + (p[2] + p[3])) * (1.f / 128.f) + EPS);
#pragma unroll
                for (int bj = 0; bj < 2; ++bj)
#pragma unroll
                    for (int n = 0; n < 2; ++n) st_bf4(KV + (size_t)row * 2048 + u.pn * 256 + EPI_CL(bj, n), acc[ai][bj][m][n] * rs); asm volatile("" ::: "memory"); }
    }
};
struct EpiZG {
    static constexpr bool PERM = false, AFTER_DRAIN = false;
    bf16 *Y, *SA, *SS;
    __device__ __forceinline__ void operator()(const f32x4 (&acc)[2][2][4][2], const Unit& u, int wr, int wc, int fr_, int fq_) const {
        int ln_ = (int)__builtin_amdgcn_mbcnt_hi(~0u, __builtin_amdgcn_mbcnt_lo(~0u, 0u)); asm volatile("" : "+v"(ln_)); const int fr = ln_ & 15, fq = ln_ >> 4; (void)fr_; (void)fq_;
        const int pn = u.pn;
#pragma unroll
        for (int ai = 0; ai < 2; ++ai)
#pragma unroll
            for (int m = 0; m < 4; ++m) { const int row = EPI_ROWS(ai, m);
#pragma unroll
                for (int bj = 0; bj < 2; ++bj)
#pragma unroll
                    for (int n = 0; n < 2; ++n) { const f32x4 z = acc[ai][bj][m][n]; const int cl = EPI_CL(bj, n);
                        if (pn < 4) { bf16* yp = Y + (size_t)row * 1024 + pn * 256 + cl; const f32x4 y = ld_bf4(yp);
                            st_bf4(yp, (f32x4){y[0] * silu(z[0]), y[1] * silu(z[1]), y[2] * silu(z[2]), y[3] * silu(z[3])}); }
                        else { bf16* gp = (pn < 8 ? SA + (size_t)row * 1024 + (pn - 4) * 256 : SS + (size_t)row * 1024 + (pn - 8) * 256) + cl;
                            st_bf4(gp, (f32x4){sigm(z[0]), sigm(z[1]), sigm(z[2]), sigm(z[3])}); } } }
    }
};
template <int SECOND> struct EpiBr {
    static constexpr bool PERM = false, AFTER_DRAIN = false;
    bf16* MRG; const bf16* G;
    __device__ __forceinline__ void operator()(const f32x4 (&acc)[2][2][4][2], const Unit& u, int wr, int wc, int fr_, int fq_) const {
        int ln_ = (int)__builtin_amdgcn_mbcnt_hi(~0u, __builtin_amdgcn_mbcnt_lo(~0u, 0u)); asm volatile("" : "+v"(ln_)); const int fr = ln_ & 15, fq = ln_ >> 4; (void)fr_; (void)fq_;
#pragma unroll
        for (int ai = 0; ai < 2; ++ai)
#pragma unroll
            for (int m = 0; m < 4; ++m) { const int row = EPI_ROWS(ai, m);
#pragma unroll
                for (int bj = 0; bj < 2; ++bj)
#pragma unroll
                    for (int n = 0; n < 2; ++n) { const size_t o = (size_t)row * 1024 + u.pn * 256 + EPI_CL(bj, n); f32x4 v = ld_bf4(G + o) * acc[ai][bj][m][n];
                        if (SECOND) v += ld_bf4(MRG + o);
                        st_bf4(MRG + o, v); } }
    }
};
struct EpiOut {
    static constexpr bool PERM = false, AFTER_DRAIN = false;
    float* H1; const float *x, *meta;
    __device__ __forceinline__ void operator()(const f32x4 (&acc)[2][2][4][2], const Unit& u, int wr, int wc, int fr_, int fq_) const {
        int ln_ = (int)__builtin_amdgcn_mbcnt_hi(~0u, __builtin_amdgcn_mbcnt_lo(~0u, 0u)); asm volatile("" : "+v"(ln_)); const int fr = ln_ & 15, fq = ln_ >> 4; (void)fr_; (void)fq_;
#pragma unroll
        for (int ai = 0; ai < 2; ++ai)
#pragma unroll
            for (int m = 0; m < 4; ++m) { const int row = EPI_ROWS(ai, m); int b; const int tok = row_tok(row, b);
                const float* src = tok < 0 ? nullptr : (tok < NMETA ? meta + (size_t)tok * DM : x + ((size_t)b * SEQ + (tok - NMETA)) * DM);
#pragma unroll
                for (int bj = 0; bj < 2; ++bj)
#pragma unroll
                    for (int n = 0; n < 2; ++n) { const int c = u.pn * 256 + EPI_CL(bj, n); f32x4 v = (f32x4){0.f, 0.f, 0.f, 0.f};
                        if (src) v = *(const f32x4*)(src + c) + acc[ai][bj][m][n];
                        *(f32x4*)(H1 + (size_t)row * 1024 + c) = v; } }
    }
};
struct EpiGU {
    static constexpr bool PERM = false, AFTER_DRAIN = false;
    bf16* HM;
    __device__ __forceinline__ void operator()(const f32x4 (&acc)[2][2][4][2], const Unit& u, int wr, int wc, int fr_, int fq_) const {
        int ln_ = (int)__builtin_amdgcn_mbcnt_hi(~0u, __builtin_amdgcn_mbcnt_lo(~0u, 0u)); asm volatile("" : "+v"(ln_)); const int fr = ln_ & 15, fq = ln_ >> 4; (void)fr_; (void)fq_;
        const int j = u.pn & 1;
#pragma unroll
        for (int ai = 0; ai < 2; ++ai)
#pragma unroll
            for (int m = 0; m < 4; ++m) { const int row = EPI_ROWS(ai, m);
#pragma unroll
                for (int n = 0; n < 2; ++n) { const f32x4 g = acc[ai][0][m][n], up = acc[ai][1][m][n];
                    st_bf4(HM + (size_t)row * 256 + j * 128 + wc * 32 + n * 16 + fq * 4, (f32x4){silu(g[0]) * up[0], silu(g[1]) * up[1], silu(g[2]) * up[2], silu(g[3]) * up[3]}); } }
    }
};
struct EpiDown {
    static constexpr bool PERM = false, AFTER_DRAIN = false;
    bf16* YP; const int* PROW; const float* TOKW;
    __device__ __forceinline__ void operator()(const f32x4 (&acc)[2][2][4][2], const Unit& u, int wr, int wc, int fr_, int fq_) const {
        int ln_ = (int)__builtin_amdgcn_mbcnt_hi(~0u, __builtin_amdgcn_mbcnt_lo(~0u, 0u)); asm volatile("" : "+v"(ln_)); const int fr = ln_ & 15, fq = ln_ >> 4; (void)fr_; (void)fq_;
        const int j = u.pn & 3;
#pragma unroll
        for (int ai = 0; ai < 2; ++ai)
#pragma unroll
            for (int m = 0; m < 4; ++m) { const int prow = EPI_ROWS(ai, m); const int code = PROW[prow];
                if (code >= 0) { const float w = TOKW[code]; bf16* dst = YP + ((size_t)(code & 1) * MROWS + (code >> 1)) * 1024 + j * 256;
#pragma unroll
                    for (int bj = 0; bj < 2; ++bj)
#pragma unroll
                        for (int n = 0; n < 2; ++n) st_bf4(dst + EPI_CL(bj, n), acc[ai][bj][m][n] * w); } }
    }
};
struct MoeOrder {
    const volatile LAS int* ost;
    int ncol, G, c;
    __device__ __forceinline__ bool next(int i, Unit& u) const {
        const int L = i * G + c, ntile = ost[NEXP] >> 8;
        if (L >= ntile * ncol) return false;
        const int rt = L / ncol, j = L - rt * ncol; int e = 0;
        for (int k = 1; k < NEXP; ++k) e += ((ost[k] >> 8) <= rt) ? 1 : 0;
        u.pm = rt; u.pn = e * ncol + j; return true;
    }
    __device__ __forceinline__ void a_ready(const Unit&) const {}
    __device__ __forceinline__ void done(const Unit&) const {}
};

__device__ __forceinline__ void tr_item(const float* __restrict__ W, int ldw, int sc0, int nvalid, int k0, const float* __restrict__ ks, float mul, bf16* WT, int K, int dn0, LAS float* scr, int lane) {
#pragma unroll 8
    for (int i = 0; i < 32; ++i) { const int kk = 2 * i + (lane >> 5), n = lane & 31; float v = 0.f;
        if (n < nvalid) { v = W[(size_t)(k0 + kk) * ldw + sc0 + n]; if (ks) v *= ks[k0 + kk]; v *= mul; }
        scr[kk * 33 + n] = v; }
    LDS_WAIT(); asm volatile("" ::: "memory");
    const int c = lane & 7;
#pragma unroll
    for (int j = 0; j < 4; ++j) { const int n = (lane >> 3) + 8 * j; const LAS float* s = scr + (8 * c) * 33 + n;
        v4u o; o.x = pk2(s[0 * 33], s[1 * 33]); o.y = pk2(s[2 * 33], s[3 * 33]); o.z = pk2(s[4 * 33], s[5 * 33]); o.w = pk2(s[6 * 33], s[7 * 33]);
        *(v4u*)(WT + (size_t)(dn0 + n) * K + k0 + 8 * c) = o; }
    LDS_WAIT(); asm volatile("" ::: "memory");
}

struct In {
    const float *x, *meta, *norm_mix, *w_in, *q_norm, *w_uq, *kv_norm, *w_ukv, *conv_w, *conv_b, *dt_bias, *a_log, *d_skip, *ssm_norm, *w_ba, *w_bs, *w_out, *norm_ffn,
                *w_group, *b_group, *w_expert, *b_expert, *w_gate, *w_up, *w_down, *norm_final;
};

__device__ __forceinline__ void p0_prologue(const In& I, unsigned char* ws, LAS unsigned char* lds, int gw, int NGW, int wave, int lane) {
    LAS float* scr = (LAS float*)(lds + wave * 16384);
    bf16 *WinA = (bf16*)(ws + WS_WINA), *WinB = (bf16*)(ws + WS_WINB), *Wuq = (bf16*)(ws + WS_WUQ), *Wukv = (bf16*)(ws + WS_WUKV), *Wba = (bf16*)(ws + WS_WBA), *Wbs = (bf16*)(ws + WS_WBS),
         *Wout = (bf16*)(ws + WS_WOUT), *Wgu = (bf16*)(ws + WS_WGU), *Wd = (bf16*)(ws + WS_WD);
    constexpr int I_A = 16 * 56, I_B = 16 * 96, I_UQ = 4 * 48, I_UKV = 2 * 64, I_SQ = 16 * 32, I_GU = 16 * 512, I_D = 4 * 1024;
    constexpr int NIT = I_A + I_B + I_UQ + I_UKV + 3 * I_SQ + I_GU + I_D;
    for (int it = gw; it < NIT; it += NGW) {
        int r = it;
        if (r < I_A) { const int kb = r / 56, n0 = (r % 56) * 32; int sc0 = 0, nv = 32;
            if (n0 < 416) sc0 = n0; else if (n0 == 416) { sc0 = 2720; nv = 16; } else if (n0 < 512) { sc0 = 0; nv = 0; } else sc0 = 1440 + (n0 - 512);
            tr_item(I.w_in, 4784, sc0, nv, kb * 64, nullptr, 1.f, WinA, 1024, n0, scr, lane); continue; }
        r -= I_A;
        if (r < I_B) { const int kb = r / 96, n0 = (r % 96) * 32; const int sc0 = n0 < 1024 ? 416 + n0 : (n0 < 2048 ? 2736 + (n0 - 1024) : 3760 + (n0 - 2048));
            tr_item(I.w_in, 4784, sc0, 32, kb * 64, nullptr, 1.f, WinB, 1024, n0, scr, lane); continue; }
        r -= I_B;
        if (r < I_UQ) { const int kb = r / 48, n0 = (r % 48) * 32; const int sc0 = n0 < 1024 ? 96 * (n0 / 64) + (n0 % 64) : 96 * ((n0 - 1024) / 32) + 64;
            tr_item(I.w_uq, 1536, sc0, 32, kb * 64, I.q_norm, QSCALE, Wuq, 256, n0, scr, lane); continue; }
        r -= I_UQ;
        if (r < I_UKV) { const int kb = r / 64, n0 = (r % 64) * 32; tr_item(I.w_ukv, 2048, n0, 32, kb * 64, I.kv_norm, 1.f, Wukv, 128, n0, scr, lane); continue; }
        r -= I_UKV;
        if (r < I_SQ) { const int kb = r / 32, n0 = (r % 32) * 32; tr_item(I.w_ba, 1024, n0, 32, kb * 64, nullptr, 1.f, Wba, 1024, n0, scr, lane); continue; }
        r -= I_SQ;
        if (r < I_SQ) { const int kb = r / 32, n0 = (r % 32) * 32; tr_item(I.w_bs, 1024, n0, 32, kb * 64, I.ssm_norm, 1.f, Wbs, 1024, n0, scr, lane); continue; }
        r -= I_SQ;
        if (r < I_SQ) { const int kb = r / 32, n0 = (r % 32) * 32; tr_item(I.w_out, 1024, n0, 32, kb * 64, nullptr, 1.f, Wout, 1024, n0, scr, lane); continue; }
        r -= I_SQ;
        if (r < I_GU) { const int kb = r / 512, n0 = (r % 512) * 32; const int e = n0 / 512, rr = n0 % 512, j = rr / 256, half = (rr % 256) / 128, c = rr % 128;
            const float* W = (half ? I.w_up : I.w_gate) + (size_t)e * 1024 * 256;
            tr_item(W, 256, 128 * j + c, 32, kb * 64, nullptr, 1.f, Wgu, 1024, n0, scr, lane); continue; }
        r -= I_GU;
        { const int kb = r / 1024, n0 = (r % 1024) * 32; const int e = n0 / 1024; const float* W = I.w_down + (size_t)e * 256 * 1024;
            tr_item(W, 1024, n0 % 1024, 32, kb * 64, nullptr, 1.f, Wd, 256, n0, scr, lane); }
    }
    float* CS = (float*)(ws + WS_CS);
    for (int idx = gw * 64 + lane; idx < LTOK * 16; idx += NGW * 64) { const int pos = idx >> 4, j = idx & 15;
        const float inv = exp2f(-(float)j * (13.287712379549449f / 16.f)); const float ang = (float)pos * inv;
        const double a = (double)ang; const double kk = rint(a * 0.15915494309189535); const float rr = (float)(a - kk * 6.283185307179586);
        CS[pos * 32 + j] = __cosf(rr); CS[pos * 32 + 16 + j] = __sinf(rr); }
    bf16* XN = (bf16*)(ws + WS_XN);
    for (int row = gw; row < MROWS; row += NGW) { int b; const int tok = row_tok(row, b);
        unsigned long long* o8 = (unsigned long long*)(XN + (size_t)row * DM) + lane;
        if (tok < 0) {
#pragma unroll
            for (int j = 0; j < 4; ++j) o8[64 * j] = 0ull;
            continue; }
        const float* src = tok < NMETA ? I.meta + (size_t)tok * DM : I.x + ((size_t)b * SEQ + (tok - NMETA)) * DM;
        f32x4 v[4]; float s = 0.f;
#pragma unroll
        for (int j = 0; j < 4; ++j) { v[j] = ((const f32x4*)src)[lane + 64 * j]; s += (v[j][0] * v[j][0] + v[j][1] * v[j][1]) + (v[j][2] * v[j][2] + v[j][3] * v[j][3]); }
        const float rs = rsqrtf(wave_sum(s) * (1.f / DM) + EPS);
#pragma unroll
        for (int j = 0; j < 4; ++j) { const f32x4 g = ((const f32x4*)I.norm_mix)[lane + 64 * j]; const f32x4 t = v[j] * rs * g;
            o8[64 * j] = (unsigned long long)pk2(t[0], t[1]) | ((unsigned long long)pk2(t[2], t[3]) << 32); }
    }
}

typedef float f32x16 __attribute__((ext_vector_type(16)));
typedef short v4i16_t __attribute__((ext_vector_type(4)));
typedef float f32x2_t __attribute__((ext_vector_type(2)));
typedef __bf16 bf16x2_t __attribute__((ext_vector_type(2)));
__device__ __forceinline__ unsigned cvtpk(float lo, float hi) { f32x2_t v = {lo, hi}; bf16x2_t b = __builtin_convertvector(v, bf16x2_t); return __builtin_bit_cast(unsigned, b); }
constexpr int AT_KP = 208, AT_VP = 144, AT_KB = 64 * AT_KP, AT_GRP = AT_KB + 64 * AT_VP;
__device__ __forceinline__ void attn_unit(int b, int hp, int qb, bf16* Qn, const bf16* Qr, const bf16* KV, const bf16* KR, LAS unsigned char* lds, int tid) {
    const int lane = tid & 63, wave = __builtin_amdgcn_readfirstlane(tid >> 6), grp = wave >> 2, wq = wave & 3, r = lane & 31, hh = lane >> 5;
    const int h = 2 * hp + grp, tg = tid & 255;
    LAS unsigned char* Kt = lds + grp * AT_GRP; LAS unsigned char* Vt = Kt + AT_KB;
    const size_t rowb = (size_t)b * LP; const int pq = qb * 128 + wq * 32 + r;
    bf16x8 qf[6];
    { const bf16* qp = Qn + (rowb + pq) * 1024 + h * 64 + 8 * hh;
#pragma unroll
      for (int ks = 0; ks < 4; ++ks) qf[ks] = *(const bf16x8*)(qp + 16 * ks);
      const bf16* rp = Qr + (rowb + pq) * 512 + h * 32 + 8 * hh; qf[4] = *(const bf16x8*)rp; qf[5] = *(const bf16x8*)(rp + 16); }
    const int k0 = tg >> 3, part = tg & 7;
    const bf16* gk = KV + (rowb + k0) * 2048 + h * 128 + part * 8;
    const bf16* gr = KR + (rowb + (tg >> 2)) * 32 + (tg & 3) * 8;
    LAS unsigned char* sk = Kt + k0 * AT_KP + part * 16; LAS unsigned char* sr = Kt + (tg >> 2) * AT_KP + 128 + (tg & 3) * 16; LAS unsigned char* sv = Vt + k0 * AT_VP + part * 16;
    const int kt_last = 2 * qb + 1;
    v4u nk0, nk1, nr, nv0, nv1;
#define AT_LOAD(kt) do { const size_t o_ = (size_t)(kt) * 64; nk0 = *(const v4u*)(gk + o_ * 2048); nk1 = *(const v4u*)(gk + (o_ + 32) * 2048); nr = *(const v4u*)(gr + o_ * 32); \
        nv0 = *(const v4u*)(gk + o_ * 2048 + 64); nv1 = *(const v4u*)(gk + (o_ + 32) * 2048 + 64); } while (0)
    AT_LOAD(1);
    f32x16 ot0, ot1;
#pragma unroll
    for (int i = 0; i < 16; ++i) { ot0[i] = 0.f; ot1[i] = 0.f; }
    float mrun = -20000.f, lrun = 0.f;
    const LAS unsigned char* ka = Kt + r * AT_KP + 16 * hh;
    const LAS unsigned char* va = Vt + (4 * hh + ((lane & 15) >> 2)) * AT_VP + (16 * ((lane >> 4) & 1) + 4 * (lane & 3)) * 2;
    for (int kt = 1; kt <= kt_last; ++kt) {
        __syncthreads();
        *(LAS v4u*)sk = nk0; *(LAS v4u*)(sk + 32 * AT_KP) = nk1; *(LAS v4u*)sr = nr; *(LAS v4u*)sv = nv0; *(LAS v4u*)(sv + 32 * AT_VP) = nv1;
        __syncthreads();
        if (kt < kt_last) AT_LOAD(kt + 1);
        f32x16 p0, p1;
#pragma unroll
        for (int i = 0; i < 16; ++i) { p0[i] = 0.f; p1[i] = 0.f; }
#pragma unroll
        for (int ks = 0; ks < 6; ++ks) { const bf16x8 a0 = *(const LAS bf16x8*)(ka + 32 * ks), a1 = *(const LAS bf16x8*)(ka + 32 * AT_KP + 32 * ks);
            p0 = __builtin_amdgcn_mfma_f32_32x32x16_bf16(a0, qf[ks], p0, 0, 0, 0); p1 = __builtin_amdgcn_mfma_f32_32x32x16_bf16(a1, qf[ks], p1, 0, 0, 0); }
        const int kbase = 64 * kt + 4 * hh; float tm = -1e30f;
#pragma unroll
        for (int i = 0; i < 16; ++i) { const int kp = kbase + (i & 3) + 8 * (i >> 2);
            if (!(kp >= PADF && kp <= pq)) p0[i] = -1e30f;
            if (!(kp + 32 >= PADF && kp + 32 <= pq)) p1[i] = -1e30f;
            tm = fmaxf(tm, fmaxf(p0[i], p1[i])); }
        tm = fmaxf(tm, __shfl_xor(tm, 32));
        const float mn = fmaxf(mrun, tm), al = __builtin_amdgcn_exp2f(mrun - mn); mrun = mn;
        float ps = 0.f;
#pragma unroll
        for (int i = 0; i < 16; ++i) { p0[i] = __builtin_amdgcn_exp2f(p0[i] - mn); p1[i] = __builtin_amdgcn_exp2f(p1[i] - mn); ps += p0[i] + p1[i]; }
        lrun = lrun * al + ps;
#pragma unroll
        for (int i = 0; i < 16; ++i) { ot0[i] *= al; ot1[i] *= al; }
        v4u w0, w1, w2, w3;
        w0.x = cvtpk(p0[0], p0[1]); w0.y = cvtpk(p0[2], p0[3]); w0.z = cvtpk(p0[4], p0[5]); w0.w = cvtpk(p0[6], p0[7]);
        w1.x = cvtpk(p0[8], p0[9]); w1.y = cvtpk(p0[10], p0[11]); w1.z = cvtpk(p0[12], p0[13]); w1.w = cvtpk(p0[14], p0[15]);
        w2.x = cvtpk(p1[0], p1[1]); w2.y = cvtpk(p1[2], p1[3]); w2.z = cvtpk(p1[4], p1[5]); w2.w = cvtpk(p1[6], p1[7]);
        w3.x = cvtpk(p1[8], p1[9]); w3.y = cvtpk(p1[10], p1[11]); w3.z = cvtpk(p1[12], p1[13]); w3.w = cvtpk(p1[14], p1[15]);
        const bf16x8 pb[4] = {__builtin_bit_cast(bf16x8, w0), __builtin_bit_cast(bf16x8, w1), __builtin_bit_cast(bf16x8, w2), __builtin_bit_cast(bf16x8, w3)};
#pragma unroll
        for (int s = 0; s < 4; ++s) {
#pragma unroll
            for (int db = 0; db < 2; ++db) { const LAS unsigned char* vp = va + (16 * s) * AT_VP + 64 * db;
                const v4i16_t lo = __builtin_amdgcn_ds_read_tr16_b64_v4i16((LAS v4i16_t*)vp), hi = __builtin_amdgcn_ds_read_tr16_b64_v4i16((LAS v4i16_t*)(vp + 8 * AT_VP));
                const bf16x8 af = (bf16x8){lo[0], lo[1], lo[2], lo[3], hi[0], hi[1], hi[2], hi[3]};
                if (db == 0) ot0 = __builtin_amdgcn_mfma_f32_32x32x16_bf16(af, pb[s], ot0, 0, 0, 0); else ot1 = __builtin_amdgcn_mfma_f32_32x32x16_bf16(af, pb[s], ot1, 0, 0, 0); } }
    }
#undef AT_LOAD
    lrun += __shfl_xor(lrun, 32);
    const float il = lrun > 0.f ? 1.f / lrun : 0.f;
    bf16* op = Qn + (rowb + pq) * 1024 + h * 64 + 4 * hh;
#pragma unroll
    for (int g4 = 0; g4 < 4; ++g4) { st_bf4(op + 8 * g4, (f32x4){ot0[4 * g4] * il, ot0[4 * g4 + 1] * il, ot0[4 * g4 + 2] * il, ot0[4 * g4 + 3] * il});
        st_bf4(op + 32 + 8 * g4, (f32x4){ot1[4 * g4] * il, ot1[4 * g4 + 1] * il, ot1[4 * g4 + 2] * il, ot1[4 * g4 + 3] * il}); }
}

__device__ __forceinline__ void ssd_naive_unit(int b, int h, const In& I, const bf16* XBC, const float* DT, bf16* Y, float* L, int tid) {
    float* Bs = L; float* XD = L + 8192; float* XS = L + 16384; float* ST = L + 24576; float* ACS = L + 28736; float* DEC = L + 28864; float* DTs = L + 28992; float* EA = L + 29120;
    const int g = h >> 3; const float Ah = -__expf(I.a_log[h]), Dh = I.d_skip[h];
    for (int e = tid; e < 64 * 65; e += 512) ST[e] = 0.f;
    const int l = tid & 127, pg = tid >> 7;
    const int cx = h * 64, cB = 1024 + g * 64, cC = 1024 + 128 + g * 64;
    for (int c = 0; c < NCHUNK; ++c) {
        const size_t r0 = (size_t)b * LP + c * 128;
        __syncthreads();
        if (tid < 128) { const int pl = c * 128 + tid; DTs[tid] = pl >= PADF ? DT[(r0 + tid) * 16 + h] : 0.f; }
        __syncthreads();
        if (tid < 128) { float a = 0.f; for (int i = 0; i <= tid; ++i) a += DTs[i] * Ah; ACS[tid] = a; }
        for (int e = tid; e < 128 * 64; e += 512) { const int ll = e >> 6, col = e & 63; const int pl = c * 128 + ll; float xv = 0.f, bv = 0.f;
            if (pl >= PADF) { float ax = I.conv_b[cx + col], ab = I.conv_b[cB + col];
#pragma unroll
                for (int k = 0; k < 4; ++k) { const size_t rr = (r0 + ll - 3 + k) * CONVD; ax += bf2f(XBC[rr + cx + col]) * I.conv_w[k * CONVD + cx + col]; ab += bf2f(XBC[rr + cB + col]) * I.conv_w[k * CONVD + cB + col]; }
                xv = silu(ax); bv = silu(ab); }
            XS[e] = xv; XD[e] = xv * DTs[ll]; Bs[e] = bv; }
        float cr[64];
        { const int pl = c * 128 + l;
#pragma unroll
          for (int n = 0; n < 64; ++n) cr[n] = 0.f;
          if (pl >= PADF) {
#pragma unroll
              for (int n = 0; n < 64; n += 4) { f32x4 a = *(const f32x4*)(I.conv_b + cC + n);
#pragma unroll
                  for (int k = 0; k < 4; ++k) { const f32x4 xv = ld_bf4(XBC + (r0 + l - 3 + k) * CONVD + cC + n); const f32x4 w = *(const f32x4*)(I.conv_w + k * CONVD + cC + n); a += xv * w; }
                  cr[n] = silu(a[0]); cr[n + 1] = silu(a[1]); cr[n + 2] = silu(a[2]); cr[n + 3] = silu(a[3]); } } }
        __syncthreads();
        if (tid < 128) { DEC[tid] = __expf(ACS[127] - ACS[tid]); EA[tid] = __expf(ACS[tid]); }
        __syncthreads();
        float ya[16];
        { const float ea = EA[l];
#pragma unroll
          for (int pi = 0; pi < 16; ++pi) { const float* sp = ST + (pg * 16 + pi) * 65; float d = 0.f;
#pragma unroll
              for (int n = 0; n < 64; ++n) d += cr[n] * sp[n];
              ya[pi] = d * ea + Dh * XS[l * 64 + pg * 16 + pi]; } }
        { const float al = ACS[l]; const int smax = (tid | 63) & 127;
          for (int s = 0; s <= smax; ++s) { const f32x4* bp = (const f32x4*)(Bs + s * 64); float cb = 0.f;
#pragma unroll
              for (int n4 = 0; n4 < 16; ++n4) { const f32x4 bv = bp[n4]; cb += cr[4 * n4] * bv[0] + cr[4 * n4 + 1] * bv[1] + cr[4 * n4 + 2] * bv[2] + cr[4 * n4 + 3] * bv[3]; }
              const float w = s <= l ? cb * __expf(al - ACS[s]) : 0.f; const f32x4* xp = (const f32x4*)(XD + s * 64 + pg * 16);
#pragma unroll
              for (int p4 = 0; p4 < 4; ++p4) { const f32x4 xv = xp[p4]; ya[4 * p4] += w * xv[0]; ya[4 * p4 + 1] += w * xv[1]; ya[4 * p4 + 2] += w * xv[2]; ya[4 * p4 + 3] += w * xv[3]; } } }
        { const int pl = c * 128 + l; bf16* yp = Y + (r0 + l) * 1024 + h * 64 + pg * 16;
#pragma unroll
          for (int p4 = 0; p4 < 4; ++p4) st_bf4(yp + 4 * p4, pl >= PADF ? (f32x4){ya[4 * p4], ya[4 * p4 + 1], ya[4 * p4 + 2], ya[4 * p4 + 3]} : (f32x4){0.f, 0.f, 0.f, 0.f}); }
        __syncthreads();
        { const int p = tid >> 3, n0 = (tid & 7) * 8; float sn[8]; const float cd = EA[127];
#pragma unroll
          for (int i = 0; i < 8; ++i) sn[i] = ST[p * 65 + n0 + i] * cd;
          for (int ll = 0; ll < 128; ++ll) { const float cf = XD[ll * 64 + p] * DEC[ll]; const f32x4 b0 = *(const f32x4*)(Bs + ll * 64 + n0), b1 = *(const f32x4*)(Bs + ll * 64 + n0 + 4);
              sn[0] += cf * b0[0]; sn[1] += cf * b0[1]; sn[2] += cf * b0[2]; sn[3] += cf * b0[3]; sn[4] += cf * b1[0]; sn[5] += cf * b1[1]; sn[6] += cf * b1[2]; sn[7] += cf * b1[3]; }
#pragma unroll
          for (int i = 0; i < 8; ++i) ST[p * 65 + n0 + i] = sn[i]; }
    }
    __syncthreads();
}

__device__ __forceinline__ void p5_groupnorm(bf16* Y, int gw, int NGW, int lane) {
    for (int row = gw; row < MROWS; row += NGW) { v4u* p = (v4u*)(Y + (size_t)row * 1024) + 2 * lane;
        const v4u a = p[0], c = p[1]; float f[16];
        f[0] = bflo(a.x); f[1] = bfhi(a.x); f[2] = bflo(a.y); f[3] = bfhi(a.y); f[4] = bflo(a.z); f[5] = bfhi(a.z); f[6] = bflo(a.w); f[7] = bfhi(a.w);
        f[8] = bflo(c.x); f[9] = bfhi(c.x); f[10] = bflo(c.y); f[11] = bfhi(c.y); f[12] = bflo(c.z); f[13] = bfhi(c.z); f[14] = bflo(c.w); f[15] = bfhi(c.w);
        float s = 0.f;
#pragma unroll
        for (int i = 0; i < 16; ++i) s += f[i] * f[i];
#pragma unroll
        for (int o = 1; o < 32; o <<= 1) s += __shfl_xor(s, o);
        const float rs = rsqrtf(s * (1.f / 512.f) + EPS);
        v4u oa, oc; oa.x = pk2(f[0] * rs, f[1] * rs); oa.y = pk2(f[2] * rs, f[3] * rs); oa.z = pk2(f[4] * rs, f[5] * rs); oa.w = pk2(f[6] * rs, f[7] * rs);
        oc.x = pk2(f[8] * rs, f[9] * rs); oc.y = pk2(f[10] * rs, f[11] * rs); oc.z = pk2(f[12] * rs, f[13] * rs); oc.w = pk2(f[14] * rs, f[15] * rs);
        p[0] = oa; p[1] = oc; }
}

__device__ __forceinline__ void p2_rowpass(const float* KRF, bf16* KR, float* DT, const float* CS, const float* dt_bias, int gtid, int nthr) {
    for (int idx = gtid; idx < MROWS * 16; idx += nthr) { const int row = idx >> 4, j = idx & 15; int b; const int tok = row_tok(row, b);
        float o1 = 0.f, o2 = 0.f, d = 0.f;
        if (tok >= 0) { const float x1 = KRF[(size_t)row * 32 + j], x2 = KRF[(size_t)row * 32 + 16 + j], c = CS[(size_t)tok * 32 + j], sn = CS[(size_t)tok * 32 + 16 + j];
            o1 = x1 * c - x2 * sn; o2 = x2 * c + x1 * sn;
            const float x = DT[idx] + dt_bias[j]; d = fmaxf(x, 0.f) + __logf(1.f + __expf(-fabsf(x))); }
        KR[(size_t)row * 32 + j] = (bf16)f2bf(o1); KR[(size_t)row * 32 + 16 + j] = (bf16)f2bf(o2); DT[idx] = d; }
}
__device__ __forceinline__ void p9_router(const In& I, unsigned char* ws, float* WE, unsigned* ctl, int gw, int NGW, int tid, int lane) {
    for (int e = tid; e < 1024 * 32; e += 512) { const int k = e >> 5, c = e & 31; WE[c * 1025 + k] = I.w_expert[e]; }
    __syncthreads();
    const float* H1 = (const float*)(ws + WS_H1); bf16* VN = (bf16*)(ws + WS_XN); float* TOKW = (float*)(ws + WS_TOKW); int* LIST = (int*)(ws + WS_LIST);
    for (int t = gw; t < TCAP; t += NGW) { const int b = t / LTOK, tok = t - b * LTOK; const int row = b * LP + PADF + tok;
        const float* hp = H1 + (size_t)row * 1024; float v[16]; float s = 0.f;
#pragma unroll
        for (int jj = 0; jj < 16; ++jj) { v[jj] = hp[lane + 64 * jj]; s += v[jj] * v[jj]; }
        const float rs = rsqrtf(wave_sum(s) * (1.f / DM) + EPS);
        float gl[4] = {0.f, 0.f, 0.f, 0.f};
#pragma unroll
        for (int jj = 0; jj < 16; ++jj) { const int k = lane + 64 * jj; v[jj] = v[jj] * rs * I.norm_ffn[k]; VN[(size_t)row * 1024 + k] = (bf16)f2bf(v[jj]);
            const f32x4 wg = *(const f32x4*)(I.w_group + 4 * k); gl[0] += v[jj] * wg[0]; gl[1] += v[jj] * wg[1]; gl[2] += v[jj] * wg[2]; gl[3] += v[jj] * wg[3]; }
#pragma unroll
        for (int i = 0; i < 4; ++i) gl[i] = wave_sum(gl[i]) + I.b_group[i];
        int g = 0; float gm = gl[0];
#pragma unroll
        for (int i = 1; i < 4; ++i) if (gl[i] > gm) { gm = gl[i]; g = i; }
        float den = 0.f;
#pragma unroll
        for (int i = 0; i < 4; ++i) den += __expf(gl[i] - gm);
        const float pg = 1.f / den;
        float el[8];
#pragma unroll
        for (int i = 0; i < 8; ++i) { const float* wp = WE + (8 * g + i) * 1025 + lane; float a = 0.f;
#pragma unroll
            for (int jj = 0; jj < 16; ++jj) a += v[jj] * wp[64 * jj];
            el[i] = wave_sum(a) + I.b_expert[8 * g + i]; }
        int i0 = 0; float v0 = el[0];
#pragma unroll
        for (int i = 1; i < 8; ++i) if (el[i] > v0) { v0 = el[i]; i0 = i; }
        int i1 = -1; float v1 = -3.0e38f;
#pragma unroll
        for (int i = 0; i < 8; ++i) if (i != i0 && el[i] > v1) { v1 = el[i]; i1 = i; }
        const float w0 = 1.f / (1.f + __expf(v1 - v0)), w1 = 1.f - w0;
        if (lane == 0) { const int e0 = 8 * g + i0, e1 = 8 * g + i1;
            const unsigned p0 = atomicAdd(ctl + CW_CNT + e0, 1u), p1 = atomicAdd(ctl + CW_CNT + e1, 1u);
            LIST[(size_t)e0 * TCAP + p0] = row * 2; LIST[(size_t)e1 * TCAP + p1] = row * 2 + 1;
            TOKW[row * 2] = w0 * pg; TOKW[row * 2 + 1] = w1 * pg; }
    }
}
__device__ __forceinline__ void moe_offsets(const unsigned* ctl, volatile LAS int* ost, int tid) {
    __syncthreads();
    if (tid == 0) { int a = 0; for (int e = 0; e < NEXP; ++e) { ost[e] = a; const int c = (int)__hip_atomic_load(ctl + CW_CNT + e, __ATOMIC_RELAXED, __HIP_MEMORY_SCOPE_AGENT); a += (c + 255) & ~255; } ost[NEXP] = a; }
    __syncthreads();
}
__device__ __forceinline__ void p10_gather(unsigned char* ws, const unsigned* ctl, volatile LAS int* ost, int gw, int NGW, int lane) {
    const bf16* VN = (const bf16*)(ws + WS_XN); bf16* VP = (bf16*)(ws + WS_VP); const int* LIST = (const int*)(ws + WS_LIST); int* PROW = (int*)(ws + WS_PROW);
    const int total = ost[NEXP];
    for (int pr = gw; pr < total; pr += NGW) { int e = 0;
        for (int k = 1; k < NEXP; ++k) e += (ost[k] <= pr) ? 1 : 0;
        const int pos = pr - ost[e]; const int cnt = (int)__hip_atomic_load(ctl + CW_CNT + e, __ATOMIC_RELAXED, __HIP_MEMORY_SCOPE_AGENT);
        v4u* dst = (v4u*)(VP + (size_t)pr * 1024) + lane;
        if (pos < cnt) { const int code = LIST[(size_t)e * TCAP + pos]; const v4u* src = (const v4u*)(VN + (size_t)(code >> 1) * 1024) + lane;
            dst[0] = src[0]; dst[64] = src[64]; if (lane == 0) PROW[pr] = code; }
        else { const v4u z = (v4u){0u, 0u, 0u, 0u}; dst[0] = z; dst[64] = z; if (lane == 0) PROW[pr] = -1; }
    }
}
__device__ __forceinline__ void p13_final(const In& I, unsigned char* ws, float* out, int gw, int NGW, int lane) {
    const float* H1 = (const float*)(ws + WS_H1); const bf16* YP = (const bf16*)(ws + WS_YP);
    for (int t = gw; t < NB * SEQ; t += NGW) { const int b = t / SEQ, i = t - b * SEQ; const size_t row = (size_t)b * LP + PADF + NMETA + i;
        f32x4 v[4]; float s = 0.f;
#pragma unroll
        for (int j = 0; j < 4; ++j) { const int c = 4 * (lane + 64 * j); v[j] = *(const f32x4*)(H1 + row * 1024 + c) + ld_bf4(YP + row * 1024 + c) + ld_bf4(YP + ((size_t)MROWS + row) * 1024 + c);
            s += (v[j][0] * v[j][0] + v[j][1] * v[j][1]) + (v[j][2] * v[j][2] + v[j][3] * v[j][3]); }
        const float rs = rsqrtf(wave_sum(s) * (1.f / DM) + EPS);
#pragma unroll
        for (int j = 0; j < 4; ++j) { const int c = 4 * (lane + 64 * j); *(f32x4*)(out + (size_t)t * DM + c) = v[j] * rs * *(const f32x4*)(I.norm_final + c); }
    }
}

#ifndef MK_ONE_LAUNCH
#define MK_ONE_LAUNCH 0
#endif
constexpr int NPHASE = 15;
struct Args { const float* in[26]; float* out; unsigned char* ws; };
template <int LO, int HI> __global__ void __launch_bounds__(512, 2) mk_fwd(Args args) {
    extern __shared__ __attribute__((aligned(16))) unsigned char lds[];
    LAS unsigned char* L3 = (LAS unsigned char*)lds;
    volatile LAS unsigned* MISC = (volatile LAS unsigned*)(L3 + MISC_OFF);
    const int tid = threadIdx.x, lane = tid & 63, wave = __builtin_amdgcn_readfirstlane(tid >> 6);
    const int G = gridDim.x; const int bx = blockIdx.x; const int vcu = (G % 8 == 0) ? (bx % 8) * (G / 8) + bx / 8 : bx;
    const int gw = vcu * 8 + wave, NGW = G * 8;
    unsigned char* ws = args.ws; unsigned* ctl = (unsigned*)(ws + WS_CTL);
    In I;
    I.x = args.in[0]; I.meta = args.in[1]; I.norm_mix = args.in[2]; I.w_in = args.in[3]; I.q_norm = args.in[4]; I.w_uq = args.in[5]; I.kv_norm = args.in[6]; I.w_ukv = args.in[7];
    I.conv_w = args.in[8]; I.conv_b = args.in[9]; I.dt_bias = args.in[10]; I.a_log = args.in[11]; I.d_skip = args.in[12]; I.ssm_norm = args.in[13]; I.w_ba = args.in[14]; I.w_bs = args.in[15];
    I.w_out = args.in[16]; I.norm_ffn = args.in[17]; I.w_group = args.in[18]; I.b_group = args.in[19]; I.w_expert = args.in[20]; I.b_expert = args.in[21]; I.w_gate = args.in[22]; I.w_up = args.in[23];
    I.w_down = args.in[24]; I.norm_final = args.in[25];
    for (int u = tid; u < (LDS_BYTES - MISC_OFF) / 4; u += 512) MISC[u] = 0u;
    __syncthreads();
    XcdBarrier bar; bar.bar = ctl + CW_BAR; bar.x = 0; bar.st = nullptr;
    if (HI - LO > 1) bar = xcd_barrier_post(ctl + CW_BAR, MISC + 8);
#ifndef PH_MASK
#define PH_MASK 0x7fff
#endif
#define IN(k) (((PH_MASK >> (k)) & 1) && LO <= (k) && (k) < HI)
#define SEAM(k) do { if (LO <= (k) && (k) + 1 < HI) xcd_barrier(bar); } while (0)

    bf16 *WinA = (bf16*)(ws + WS_WINA), *WinB = (bf16*)(ws + WS_WINB), *Wuq = (bf16*)(ws + WS_WUQ), *Wukv = (bf16*)(ws + WS_WUKV), *Wba = (bf16*)(ws + WS_WBA), *Wbs = (bf16*)(ws + WS_WBS),
         *Wout = (bf16*)(ws + WS_WOUT), *Wgu = (bf16*)(ws + WS_WGU), *Wd = (bf16*)(ws + WS_WD);
    float* CS = (float*)(ws + WS_CS);
    bf16 *XN = (bf16*)(ws + WS_XN), *KV = (bf16*)(ws + WS_KV), *SA = (bf16*)(ws + WS_SA), *SS = (bf16*)(ws + WS_SS), *XBC = (bf16*)(ws + WS_XBC), *MRG = (bf16*)(ws + WS_MRG), *Y = (bf16*)(ws + WS_Y),
         *CQ = (bf16*)(ws + WS_CQ), *CKV = (bf16*)(ws + WS_CKV), *KR = (bf16*)(ws + WS_KR), *VP = (bf16*)(ws + WS_VP), *YP = (bf16*)(ws + WS_YP), *HM = (bf16*)(ws + WS_HM);
    float *H1 = (float*)(ws + WS_H1), *DT = (float*)(ws + WS_DT), *SSQ = (float*)(ws + WS_SSQ), *SSKV = (float*)(ws + WS_SSKV), *TOKW = (float*)(ws + WS_TOKW);
    int* PROW = (int*)(ws + WS_PROW); float* KRF = (float*)(ws + WS_KRF);
    bf16 *Qn = (bf16*)args.out, *Qr = (bf16*)args.out + (size_t)MROWS * 1024;

    if constexpr (IN(0)) { p0_prologue(I, ws, L3, gw, NGW, wave, lane); }
    SEAM(0);
    if constexpr (IN(1)) {
        pg8::Gemm g{XN, WinA, MROWS, 1792, 1024}; pg8::StaticOrder S; S.init(MROWS, 1792, G, bx);
        EpiInA E{CQ, CKV, XBC, KRF, DT, SSQ, SSKV};
        pg8::gemm_phase<EpiInA, pg8::StaticOrder, true, true>(L3, g, S, E);
    }
    SEAM(1);
    if constexpr (IN(2)) {
        p2_rowpass(KRF, KR, DT, CS, I.dt_bias, gw * 64 + lane, NGW * 64);
        pg8::Gemm g{CQ, Wuq, MROWS, 1536, 256}; pg8::StaticOrder S; S.init(MROWS, 1536, G, bx); EpiQ E{Qn, Qr, SSQ, CS};
        pg8::gemm_phase<EpiQ, pg8::StaticOrder, true, true>(L3, g, S, E);
    }
    if constexpr (LO <= 2 && 3 < HI) __syncthreads();
    if constexpr (IN(3)) {
        pg8::Gemm g{CKV, Wukv, MROWS, 2048, 128}; pg8::StaticOrder S; S.init(MROWS, 2048, G, bx); EpiKV E{KV, SSKV};
        pg8::gemm_phase<EpiKV, pg8::StaticOrder, true, true>(L3, g, S, E);
    }
    SEAM(3);
    if constexpr (IN(4)) {
        constexpr int NSSD = NB * NHEAD, NATT = 33 * 64;
#ifndef NO_SSD
        for (;;) {
            __syncthreads();
            if (tid == 0) MISC[0] = atomicAdd(ctl + CW_Q3, 1u);
            __syncthreads();
            const int u = (int)MISC[0];
            if (u >= NSSD) break;
            ssd_naive_unit(u >> 4, u & 15, I, XBC, DT, Y, (float*)lds, tid);
        }
#endif
#ifndef NO_ATT
        for (;;) {
            __syncthreads();
            if (tid == 0) MISC[1] = atomicAdd(ctl + CW_Q3 + 1, 1u);
            __syncthreads();
            const int a = (int)MISC[1];
            if (a >= NATT) break;
            const int qb = 32 - a / 64, rem = a % 64; attn_unit(rem >> 3, rem & 7, qb, Qn, Qr, KV, KR, L3, tid);
        }
#endif
    }
    SEAM(4);
    if constexpr (IN(5)) {
        pg8::Gemm g{XN, WinB, MROWS, 3072, 1024}; pg8::StaticOrder S; S.init(MROWS, 3072, G, bx); EpiZG E{Y, SA, SS};
        pg8::gemm_phase<EpiZG, pg8::StaticOrder, true, true>(L3, g, S, E);
    }
    SEAM(5);
    if constexpr (IN(6)) { p5_groupnorm(Y, gw, NGW, lane); }
    SEAM(6);
    if constexpr (IN(7)) {
        pg8::Gemm g{Qn, Wba, MROWS, 1024, 1024}; pg8::StaticOrder S; S.init(MROWS, 1024, G, bx); EpiBr<0> E{MRG, SA};
        pg8::gemm_phase<EpiBr<0>, pg8::StaticOrder, true, true>(L3, g, S, E);
    }
    SEAM(7);
    if constexpr (IN(8)) {
        pg8::Gemm g{Y, Wbs, MROWS, 1024, 1024}; pg8::StaticOrder S; S.init(MROWS, 1024, G, bx); EpiBr<1> E{MRG, SS};
        pg8::gemm_phase<EpiBr<1>, pg8::StaticOrder, true, true>(L3, g, S, E);
    }
    SEAM(8);
    if constexpr (IN(9)) {
        pg8::Gemm g{MRG, Wout, MROWS, 1024, 1024}; pg8::StaticOrder S; S.init(MROWS, 1024, G, bx); EpiOut E{H1, I.x, I.meta};
        pg8::gemm_phase<EpiOut, pg8::StaticOrder, true, true>(L3, g, S, E);
    }
    SEAM(9);
    if constexpr (IN(10)) { p9_router(I, ws, (float*)lds, ctl, gw, NGW, tid, lane); }
    SEAM(10);
    volatile LAS int* ost = (volatile LAS int*)(MISC + 16);
    if constexpr (IN(11)) { moe_offsets(ctl, ost, tid); p10_gather(ws, ctl, ost, gw, NGW, lane); }
    SEAM(11);
    if constexpr (IN(12)) {
        moe_offsets(ctl, ost, tid);
        pg8::Gemm g{VP, Wgu, VPROWS, 16384, 1024}; MoeOrder S{ost, 2, G, bx}; EpiGU E{HM};
        pg8::gemm_phase<EpiGU, MoeOrder, true, true>(L3, g, S, E);
    }
    SEAM(12);
    if constexpr (IN(13)) {
        moe_offsets(ctl, ost, tid);
        pg8::Gemm g{HM, Wd, VPROWS, 32768, 256}; MoeOrder S{ost, 4, G, bx}; EpiDown E{YP, PROW, TOKW};
        pg8::gemm_phase<EpiDown, MoeOrder, true, true>(L3, g, S, E);
    }
    SEAM(13);
    if constexpr (IN(14)) { p13_final(I, ws, args.out, gw, NGW, lane); }
#undef IN
#undef SEAM
}

template <int P> static void launch_phases(int grid, hipStream_t stream, const Args& a) {
    if constexpr (P < NPHASE) { hipLaunchKernelGGL((mk_fwd<P, P + 1>), dim3(grid), dim3(512), LDS_BYTES, stream, a); launch_phases<P + 1>(grid, stream, a); }
}
template <int P> static bool set_attr_phases() {
    if constexpr (P < NPHASE) { if (hipFuncSetAttribute((const void*)mk_fwd<P, P + 1>, hipFuncAttributeMaxDynamicSharedMemorySize, LDS_BYTES) != hipSuccess) return false; return set_attr_phases<P + 1>(); }
    else return true;
}
extern "C" void kernel_launch(void* const* d_in, const int* in_sizes, int n_in, void* d_out, int out_size, void* d_ws, size_t ws_size, hipStream_t stream) {
    static int grid = 0;
    if (grid == 0) {
        if (n_in != 26 || out_size != NB * SEQ * DM || ws_size < WS_END) { fprintf(stderr, "kernel_launch: unexpected problem (n_in %d, out %d, ws %zu); nothing launched\n", n_in, out_size, ws_size); grid = -1; return; }
        int dev = 0, cus = 0;
        if (hipGetDevice(&dev) != hipSuccess || hipDeviceGetAttribute(&cus, hipDeviceAttributeMultiprocessorCount, dev) != hipSuccess) { grid = -1; return; }
#if MK_ONE_LAUNCH
        if (hipFuncSetAttribute((const void*)mk_fwd<0, NPHASE>, hipFuncAttributeMaxDynamicSharedMemorySize, LDS_BYTES) != hipSuccess) { fprintf(stderr, "kernel_launch: hipFuncSetAttribute failed\n"); grid = -1; return; }
        int per_cu = 0;
        if (hipOccupancyMaxActiveBlocksPerMultiprocessor(&per_cu, (const void*)mk_fwd<0, NPHASE>, 512, LDS_BYTES) != hipSuccess || per_cu < 1) fprintf(stderr, "kernel_launch: occupancy query says %d\n", per_cu);
#else
        if (!set_attr_phases<0>()) { fprintf(stderr, "kernel_launch: hipFuncSetAttribute failed\n"); grid = -1; return; }
#endif
        (void)hipGetLastError();
        grid = cus;
    }
    if (grid < 0) return;
    (void)hipMemsetAsync((char*)d_ws + WS_CTL, 0, CTL_ZERO_BYTES, stream);
    Args a{};
    for (int i = 0; i < 26; ++i) a.in[i] = (const float*)d_in[i];
    a.out = (float*)d_out; a.ws = (unsigned char*)d_ws;
#if MK_ONE_LAUNCH
    hipLaunchKernelGGL((mk_fwd<0, NPHASE>), dim3(grid), dim3(512), LDS_BYTES, stream, a);
#else
    launch_phases<0>(grid, stream, a);
#endif
}
```

```cpp
#include <hip/hip_runtime.h>
#include <cstdio>
#include <cstdint>
namespace pg8 {
#define PG8_LAS __attribute__((address_space(3)))
typedef unsigned short bf16_t;
typedef short bf16x8 __attribute__((ext_vector_type(8)));
typedef float f32x4 __attribute__((ext_vector_type(4)));
typedef unsigned u32x4 __attribute__((ext_vector_type(4)));
constexpr int BM = 256, BK = 64, HALF = 128, HTB = HALF * BK * 2  , STAGE_BYTES = 8 * HTB, NXCD = 8, WGM = 8;

__host__ __device__ __forceinline__ int lds_byte(int r, int c) { const int st = (r >> 4) * 2 + (c >> 5), rr = r & 15, cc = c & 31, ob = rr * 64 + cc * 2; return st * 1024 + (ob ^ (((ob >> 9) & 1) << 5)); }
__host__ __device__ __forceinline__ void stage_rc(int b, int& R, int& C) { const int st = b / 1024, sb = b % 1024, swz = sb ^ (((sb >> 9) & 1) << 5); R = (st >> 1) * 16 + swz / 64; C = (st & 1) * 32 + (swz % 64) / 2; }
__host__ __device__ __forceinline__ int perm32(int rho) { const int n = rho >> 4, i = rho & 15; return 8 * (i >> 2) + 4 * n + (i & 3); }

struct Unit { int pm, pn; };
struct Gemm { const bf16_t* A; const bf16_t* Bt; int M, N, K; };

struct StaticOrder {
    int nM, nN, nwg, G, c;
    __host__ __device__ void init(int M, int N, int G_, int c_) { nM = M / BM; nN = N / BM; nwg = nM * nN; G = G_; c = c_; }
    __host__ __device__ bool next(int i, Unit& u) const {
        const long L = (long)i * G + c; if (L >= nwg) return false;
        int wgid = (int)L; { const int q = nwg / NXCD, r = nwg % NXCD, xcd = wgid % NXCD, off = wgid / NXCD; wgid = (xcd < r ? xcd * (q + 1) : r * (q + 1) + (xcd - r) * q) + off; }
        const int nig = WGM * nN, gid = wgid / nig, fm = gid * WGM, gsz = (nM - fm) < WGM ? (nM - fm) : WGM;
        u.pm = fm + ((wgid % nig) % gsz); u.pn = (wgid % nig) / gsz; return true;
    }
    __device__ __forceinline__ void a_ready(const Unit&) const {}
    __device__ __forceinline__ void done(const Unit&) const {}
};

__device__ __forceinline__ unsigned cvt_pk_bf16(float lo, float hi) { unsigned r; asm volatile("v_cvt_pk_bf16_f32 %0, %1, %2" : "=v"(r) : "v"(lo), "v"(hi)); return r; }
template <class Epi, class Sched, bool ALIGN_EPI = false, bool SP2 = false, bool GATHER = false>
__device__ __forceinline__ void gemm_phase(PG8_LAS unsigned char* lds, const Gemm g, const Sched& S, const Epi& E, const int* gidx = nullptr) {
    int tid_ = threadIdx.x; asm volatile("" : "+v"(tid_));
    const int tid = tid_, wid = __builtin_amdgcn_readfirstlane(tid >> 6), lane = tid & 63, wr = wid >> 2, wc = wid & 3, fr = lane & 15, fq = lane >> 4;
    const int K = g.K, nt = K / BK;
    unsigned voffA[2], voffB[2]; int gR[2]; unsigned gC[2];
#pragma unroll
    for (int i = 0; i < 2; ++i) { int R, C; stage_rc(tid * 16 + i * 8192, R, C); const int Rb = Epi::PERM ? ((R & ~31) + perm32(R & 31)) : R;
        voffA[i] = (unsigned)(R * K + C) * 2u; voffB[i] = (unsigned)(Rb * K + C) * 2u; gR[i] = R; gC[i] = (unsigned)C * 2u; }
    unsigned gA0[2] = {0u, 0u}, gA1[2] = {0u, 0u}, nA0[2] = {0u, 0u}, nA1[2] = {0u, 0u};
#define PG8_GOFF(o0, o1, pm_) do { _Pragma("unroll") for (int _i = 0; _i < 2; ++_i) { o0[_i] = (unsigned)gidx[(pm_) * 128 + gR[_i]] * (unsigned)(K * 2) + gC[_i]; o1[_i] = (unsigned)gidx[(pm_) * 128 + 128 + gR[_i]] * (unsigned)(K * 2) + gC[_i]; } } while (0)
#define PG8_STAGE_A(bufoff, kb, h, nx) do { if constexpr (GATHER) { unsigned _o[2]; _o[0] = (nx) ? ((h) ? nA1[0] : nA0[0]) : ((h) ? gA1[0] : gA0[0]); _o[1] = (nx) ? ((h) ? nA1[1] : nA0[1]) : ((h) ? gA1[1] : gA0[1]); PG8_STAGE(bufoff, (const char*)g.A + (kb), _o); } \
        else { PG8_STAGE(bufoff, ((nx) ? nA : cA) + (kb) + (size_t)(h) * hstep, voffA); } } while (0)
    const size_t kstep = (size_t)(BK * 2);
    const size_t hstep = (size_t)HALF * K * 2;
    const size_t tstep = 2 * hstep;
    const unsigned ldsw = (unsigned)wid * 1024u;
    const int aoff = lds_byte(wr * 64 + fr, fq * 8), boff = lds_byte(wc * 32 + fr, fq * 8);
#define PG8_SA(b, h) (((b) * 2 + (h)) * HTB)
#define PG8_SB(b, h) ((4 + (b) * 2 + (h)) * HTB)
#define PG8_STAGE(bufoff, gbase, voff) do { _Pragma("unroll") for (int _i = 0; _i < 2; ++_i) \
        __builtin_amdgcn_global_load_lds((const unsigned*)((const char*)(gbase) + (voff)[_i]), (PG8_LAS unsigned*)(lds + (bufoff) + ldsw + _i * 8192), 16, 0, 0); } while (0)
#define PG8_LDA(dst, b, h) do { _Pragma("unroll") for (int m = 0; m < 4; ++m) _Pragma("unroll") for (int k = 0; k < 2; ++k) dst[m][k] = *(const PG8_LAS bf16x8*)(lds + PG8_SA(b, h) + aoff + m * 2048 + k * 1024); } while (0)
#define PG8_LDB(dst, b, h) do { _Pragma("unroll") for (int n = 0; n < 2; ++n) _Pragma("unroll") for (int k = 0; k < 2; ++k) dst[n][k] = *(const PG8_LAS bf16x8*)(lds + PG8_SB(b, h) + boff + n * 2048 + k * 1024); } while (0)
#define PG8_MMA(ai, bj, At, Bt) do { __builtin_amdgcn_s_setprio(1); _Pragma("unroll") for (int m = 0; m < 4; ++m) _Pragma("unroll") for (int n = 0; n < 2; ++n) _Pragma("unroll") for (int k = 0; k < 2; ++k) \
        acc[ai][bj][m][n] = __builtin_amdgcn_mfma_f32_16x16x32_bf16(Bt[n][k], At[m][k], acc[ai][bj][m][n], 0, 0, 0); __builtin_amdgcn_s_setprio(0); } while (0)
#define PG8_WAIT_V(n) asm volatile("s_waitcnt vmcnt(" #n ")" ::: "memory")
#define PG8_WAIT_L(n) asm volatile("s_waitcnt lgkmcnt(" #n ")" ::: "memory")
#define PG8_BAR __builtin_amdgcn_s_barrier()
#define PG8_SCHED __builtin_amdgcn_sched_barrier(0)
    Unit cur, nxt; int ui = 0;
    if (!S.next(0, cur)) return;
    f32x4 acc[2][2][4][2];
#pragma unroll
    for (int a = 0; a < 2; ++a)
#pragma unroll
        for (int b = 0; b < 2; ++b)
#pragma unroll
            for (int m = 0; m < 4; ++m)
#pragma unroll
                for (int n = 0; n < 2; ++n) acc[a][b][m][n] = (f32x4){0.f, 0.f, 0.f, 0.f};
    bf16x8 At[4][2], B0[2][2], B1[2][2];
    const char* cA = (const char*)g.A + (size_t)cur.pm * hstep; const char* cB = (const char*)g.Bt + (size_t)cur.pn * tstep;
    if constexpr (GATHER) PG8_GOFF(gA0, gA1, cur.pm);
    const char* nA = cA;
    S.a_ready(cur);
    if constexpr (SP2) {
        PG8_STAGE(PG8_SB(0, 0), cB, voffB); PG8_STAGE(PG8_SB(0, 1), cB + hstep, voffB); PG8_STAGE_A(PG8_SA(0, 0), 0, 0, false); PG8_STAGE_A(PG8_SA(0, 1), 0, 1, false);
        if (wr == 1) PG8_BAR;
        PG8_WAIT_V(2); PG8_BAR;
        PG8_STAGE(PG8_SB(1, 0), cB + kstep, voffB); PG8_STAGE_A(PG8_SA(1, 0), kstep, 0, false); PG8_STAGE(PG8_SB(1, 1), cB + hstep + kstep, voffB);
        PG8_WAIT_V(6); PG8_BAR;
    } else {
        PG8_STAGE(PG8_SB(0, 0), cB, voffB); PG8_STAGE_A(PG8_SA(0, 0), 0, 0, false); PG8_STAGE(PG8_SB(0, 1), cB + hstep, voffB); PG8_STAGE_A(PG8_SA(0, 1), 0, 1, false);
        if (wr == 1) PG8_BAR;
        PG8_WAIT_V(4); PG8_BAR;
        PG8_STAGE(PG8_SB(1, 0), cB + kstep, voffB); PG8_STAGE_A(PG8_SA(1, 0), kstep, 0, false); PG8_STAGE(PG8_SB(1, 1), cB + hstep + kstep, voffB);
        PG8_WAIT_V(6); PG8_BAR;
    }
    for (;;) {
        const bool has_next = S.next(ui + 1, nxt);
        nA = has_next ? (const char*)g.A + (size_t)nxt.pm * hstep : cA; const char* nB = has_next ? (const char*)g.Bt + (size_t)nxt.pn * tstep : cB;
        if constexpr (GATHER) { if (has_next) PG8_GOFF(nA0, nA1, nxt.pm); else { nA0[0] = gA0[0]; nA0[1] = gA0[1]; nA1[0] = gA1[0]; nA1[1] = gA1[1]; } }
        for (int t = 0; t < nt; t += 2) {
            const bool last = (t == nt - 2);
            const size_t k1 = (size_t)(t + 1) * kstep;
            const size_t k2 = last ? 0 : (size_t)(t + 2) * kstep; const char* b2 = last ? nB : cB + (size_t)(t + 2) * kstep;
            const size_t k3 = k2 + kstep; const char* b3 = b2 + kstep;
            if (last && has_next) S.a_ready(nxt);
            if constexpr (SP2) {
            PG8_LDB(B0, 0, 0); PG8_LDB(B1, 0, 1); PG8_SCHED; PG8_LDA(At, 0, 0); PG8_STAGE_A(PG8_SA(1, 1), k1, 1, false);
            PG8_WAIT_V(8); PG8_WAIT_L(0); PG8_BAR; PG8_MMA(0, 0, At, B0); PG8_MMA(0, 1, At, B1); PG8_BAR; PG8_SCHED;
            PG8_LDA(At, 0, 1); PG8_STAGE(PG8_SB(0, 0), b2, voffB); PG8_STAGE(PG8_SB(0, 1), b2 + hstep, voffB); PG8_STAGE_A(PG8_SA(0, 0), k2, 0, last);
            PG8_WAIT_V(8); PG8_WAIT_L(0); PG8_BAR; PG8_MMA(1, 0, At, B0); PG8_MMA(1, 1, At, B1); PG8_BAR; PG8_SCHED;
            PG8_LDB(B0, 1, 0); PG8_LDB(B1, 1, 1); PG8_SCHED; PG8_LDA(At, 1, 0); PG8_STAGE_A(PG8_SA(0, 1), k2, 1, last);
            PG8_WAIT_V(8); PG8_WAIT_L(0); PG8_BAR; PG8_MMA(0, 0, At, B0); PG8_MMA(0, 1, At, B1); PG8_BAR; PG8_SCHED;
            PG8_LDA(At, 1, 1); PG8_STAGE(PG8_SB(1, 0), b3, voffB); PG8_STAGE(PG8_SB(1, 1), b3 + hstep, voffB); PG8_STAGE_A(PG8_SA(1, 0), k3, 0, last);
            PG8_WAIT_V(8); PG8_WAIT_L(0); PG8_BAR; PG8_MMA(1, 0, At, B0); PG8_MMA(1, 1, At, B1); PG8_BAR; PG8_SCHED;
            } else {
            PG8_LDB(B0, 0, 0); PG8_SCHED; PG8_LDA(At, 0, 0); PG8_STAGE_A(PG8_SA(1, 1), k1, 1, false);
            PG8_WAIT_L(8); PG8_BAR; PG8_WAIT_L(0); PG8_MMA(0, 0, At, B0); PG8_BAR; PG8_SCHED;
            PG8_LDB(B1, 0, 1); PG8_STAGE(PG8_SB(0, 0), b2, voffB);
            PG8_BAR; PG8_WAIT_L(0); PG8_MMA(0, 1, At, B1); PG8_BAR;
            PG8_LDA(At, 0, 1); PG8_STAGE_A(PG8_SA(0, 0), k2, 0, last);
            PG8_BAR; PG8_WAIT_L(0); PG8_MMA(1, 0, At, B0); PG8_BAR; PG8_SCHED;
            PG8_STAGE(PG8_SB(0, 1), b2 + hstep, voffB);
            PG8_WAIT_V(6); PG8_BAR; PG8_MMA(1, 1, At, B1); PG8_BAR;
            PG8_LDB(B0, 1, 0); PG8_SCHED; PG8_LDA(At, 1, 0); PG8_STAGE_A(PG8_SA(0, 1), k2, 1, last);
            PG8_WAIT_L(8); PG8_BAR; PG8_WAIT_L(0); PG8_MMA(0, 0, At, B0); PG8_BAR; PG8_SCHED;
            PG8_LDB(B1, 1, 1); PG8_STAGE(PG8_SB(1, 0), b3, voffB);
            PG8_BAR; PG8_WAIT_L(0); PG8_MMA(0, 1, At, B1); PG8_BAR;
            PG8_LDA(At, 1, 1); PG8_STAGE_A(PG8_SA(1, 0), k3, 0, last);
            PG8_BAR; PG8_WAIT_L(0); PG8_MMA(1, 0, At, B0); PG8_BAR; PG8_SCHED;
            PG8_STAGE(PG8_SB(1, 1), b3 + hstep, voffB);
            PG8_WAIT_V(6); PG8_BAR; PG8_MMA(1, 1, At, B1); PG8_BAR;
            }
        }
        if constexpr (ALIGN_EPI) { if (wr == 0) PG8_BAR; }
        if constexpr (!Epi::AFTER_DRAIN) { E(acc, cur, wr, wc, fr, fq); S.done(cur); }
        if (!has_next) break;
#pragma unroll
        for (int a = 0; a < 2; ++a)
#pragma unroll
            for (int b = 0; b < 2; ++b)
#pragma unroll
                for (int m = 0; m < 4; ++m)
#pragma unroll
                    for (int n = 0; n < 2; ++n) acc[a][b][m][n] = (f32x4){0.f, 0.f, 0.f, 0.f};
        cur = nxt; cA = nA; cB = nB; ++ui;
        if constexpr (GATHER) { gA0[0] = nA0[0]; gA0[1] = nA0[1]; gA1[0] = nA1[0]; gA1[1] = nA1[1]; }
        if constexpr (ALIGN_EPI) { if (wr == 1) PG8_BAR; }
    }
    PG8_WAIT_V(0);
    if constexpr (!ALIGN_EPI) { if (wr == 0) PG8_BAR; }
    PG8_BAR;
    if constexpr (Epi::AFTER_DRAIN) { E.fused(acc, cur, wr, wc, fr, fq, lds, wid, lane); S.done(cur); }
#undef PG8_SA
#undef PG8_SB
#undef PG8_STAGE
#undef PG8_STAGE_A
#undef PG8_GOFF
#undef PG8_LDA
#undef PG8_LDB
#undef PG8_MMA
#undef PG8_WAIT_V
#undef PG8_WAIT_L
#undef PG8_BAR
#undef PG8_SCHED
}
}
#define GAS __attribute__((address_space(1)))
#define LAS __attribute__((address_space(3)))
typedef unsigned short bf16;
typedef unsigned v4u __attribute__((ext_vector_type(4)));
typedef float f32x4 __attribute__((ext_vector_type(4)));
typedef short bf16x8 __attribute__((ext_vector_type(8)));
typedef GAS unsigned gu32;
typedef GAS unsigned long long gu64;
#define RLX_AGENT __ATOMIC_RELAXED, __HIP_MEMORY_SCOPE_AGENT
#define LDS_WAIT() asm volatile("s_waitcnt lgkmcnt(0)" ::: "memory")
#define VM_WAIT() asm volatile("s_waitcnt vmcnt(0)" ::: "memory")
__device__ __forceinline__ unsigned long long rt() { return __builtin_amdgcn_s_memrealtime(); }
__device__ __forceinline__ unsigned f2bf(float f) { unsigned u = __builtin_bit_cast(unsigned, f); return (u + 0x7fffu + ((u >> 16) & 1u)) >> 16; }
__device__ __forceinline__ unsigned pk2(float lo, float hi) { return f2bf(lo) | (f2bf(hi) << 16); }
#define XB_TMO      128
#define XB_XCNT(j)  (256  + 64 * (j))
#define XB_XSUB(j)  (1280 + 64 * (j))
#define XB_XGEN(j)  (2304 + 64 * (j))
#define XB_TOP      3328
#define XB_TOPGEN   3392
#define XCD_BAR_WORDS 3456
#define XB_SPIN_CAP (1u << 18)

__device__ __forceinline__ unsigned xb_ld(unsigned* p)              { return __hip_atomic_load(p, __ATOMIC_RELAXED, __HIP_MEMORY_SCOPE_AGENT); }
__device__ __forceinline__ unsigned xb_add(unsigned* p, unsigned v) { return __hip_atomic_fetch_add(p, v, __ATOMIC_RELAXED, __HIP_MEMORY_SCOPE_AGENT); }
__device__ __forceinline__ unsigned xb_xcc_id() { return (unsigned)__builtin_amdgcn_s_getreg((3 << 11) | 20) & 0xFu; }
#define XB_SPIN(cond, bar) do { unsigned _sp = 0; while (cond) { __builtin_amdgcn_s_sleep(1); \
    if ((++_sp & 255u) == 0u) { if (xb_ld(&(bar)[XB_TMO])) break; if (_sp > XB_SPIN_CAP) { atomicAdd(&(bar)[XB_TMO], 1u); break; } } } } while (0)

struct XcdBarrier {
    unsigned* bar; unsigned x;
    volatile LAS unsigned* st;
};

__device__ __forceinline__ XcdBarrier xcd_barrier_post(unsigned* bar, volatile LAS unsigned* st) {
    XcdBarrier b; b.bar = bar; b.x = xb_xcc_id(); b.st = st;
    if (threadIdx.x == 0) (void)xb_add(&bar[XB_XCNT(b.x)], 1u);
    return b;
}
__device__ __forceinline__ void xcd_barrier_complete(unsigned* bar, unsigned x, unsigned& nloc, unsigned& nx) {
    const unsigned G = gridDim.x * gridDim.y * gridDim.z;
    unsigned sum, cnt, mine, sp = 0u;
    for (;;) {
        sum = 0u; cnt = 0u; mine = 0u;
#pragma unroll
        for (unsigned j = 0; j < 16; ++j) { const unsigned c = xb_ld(&bar[XB_XCNT(j)]); sum += c; cnt += (c > 0u) ? 1u : 0u; mine = (j == x) ? c : mine; }
        if (sum == G) break;
        __builtin_amdgcn_s_sleep(1);
        if ((++sp & 255u) == 0u) { if (xb_ld(&bar[XB_TMO])) break; if (sp > XB_SPIN_CAP) { atomicAdd(&bar[XB_TMO], 1u); break; } }
    }
    nloc = mine > 0u ? mine : 1u; nx = cnt > 0u ? cnt : 1u;
}

__device__ __forceinline__ void xcd_barrier(const XcdBarrier& b) {
    asm volatile("s_waitcnt vmcnt(0)" ::: "memory");
    __syncthreads();
    if (threadIdx.x == 0) {
        unsigned* bar = b.bar;
        __builtin_amdgcn_s_waitcnt(0);
        unsigned nloc = b.st[0], nx = b.st[1];
        if (nloc == 0u) { xcd_barrier_complete(bar, b.x, nloc, nx); b.st[0] = nloc; b.st[1] = nx; }
        const unsigned old = xb_add(&bar[XB_XSUB(b.x)], 1u);
        const unsigned gen = old / nloc;
        if (old + 1u == (gen + 1u) * nloc) {
            __builtin_amdgcn_fence(__ATOMIC_RELEASE, "agent");
            asm volatile("s_waitcnt vmcnt(0)" ::: "memory");
            const unsigned og = xb_add(&bar[XB_TOP], 1u);
            const unsigned tg = og / nx;
            if (og + 1u == (tg + 1u) * nx) xb_add(&bar[XB_TOPGEN], 1u);
            else XB_SPIN(xb_ld(&bar[XB_TOPGEN]) == tg, bar);
            __builtin_amdgcn_fence(__ATOMIC_ACQUIRE, "agent");
            xb_add(&bar[XB_XGEN(b.x)], 1u);
            asm volatile("s_waitcnt vmcnt(0)" ::: "memory");
        } else {
            XB_SPIN(xb_ld(&bar[XB_XGEN(b.x)]) == gen, bar);
            __builtin_amdgcn_fence(__ATOMIC_ACQUIRE, "agent");
            asm volatile("s_waitcnt vmcnt(0)" ::: "memory");
        }
    }
    __syncthreads();
}

constexpr int DM = 1024, NB = 8, SEQ = 4096, NMETA = 16, LTOK = SEQ + NMETA, PADF = 112, LP = LTOK + PADF, MROWS = NB * LP;
constexpr int NHEAD = 16, CONVD = 1280, NCHUNK = LP / 128;
constexpr int NEXP = 32, TCAP = NB * SEQ;
constexpr int VPROWS = 74240;
constexpr float EPS = 1e-6f;
constexpr float QSCALE = 0.10206207261596575f * 1.4426950408889634f;
static_assert(LP % 128 == 0 && MROWS % 256 == 0, "row geometry");

constexpr size_t MiB = 1u << 20;
constexpr size_t WS_CTL = 0, CTL_ZERO_BYTES = 1 * MiB;
constexpr size_t WS_WINA = 1 * MiB, WS_WINB = WS_WINA + 3584 * 1024, WS_WUQ = WS_WINB + 6 * MiB, WS_WUKV = WS_WUQ + 768 * 1024, WS_WBA = 12 * MiB, WS_WBS = 14 * MiB, WS_WOUT = 16 * MiB,
                 WS_WGU = 18 * MiB, WS_WD = 50 * MiB, WS_CS = 66 * MiB;
constexpr size_t WS_XN = 68 * MiB;
constexpr size_t WS_KV = 134 * MiB;
constexpr size_t WS_SA = WS_KV, WS_SS = WS_KV + 66 * MiB, WS_H1 = WS_KV;
constexpr size_t WS_XBC = 266 * MiB;
constexpr size_t WS_MRG = WS_XBC, WS_Z = WS_XBC;
constexpr size_t WS_DL = WS_H1;
constexpr size_t WS_Y = 349 * MiB;
constexpr size_t WS_CQ = 415 * MiB, WS_CKV = 432 * MiB, WS_KR = 441 * MiB, WS_DT = 444 * MiB, WS_SSQ = 447 * MiB, WS_SSKV = 448 * MiB, WS_KRF = 462 * MiB;
constexpr size_t WS_VP = 266 * MiB;
constexpr size_t WS_YP = WS_VP;
constexpr size_t WS_HM = 415 * MiB;
constexpr size_t WS_TOKW = 452 * MiB, WS_TOKE = 453 * MiB, WS_HIST = 454 * MiB, WS_CNTG = 455 * MiB, WS_PROW = 458 * MiB, WS_GIDX = 459 * MiB, WS_END = 460 * MiB;
static_assert(WS_WUKV + 2048 * 128 * 2 <= WS_WBA && WS_VP + (size_t)VPROWS * 2048 <= WS_HM && WS_HM + (size_t)VPROWS * 512 <= WS_TOKW, "ws map");

constexpr int CW_TMO = 0, CW_Q3 = 64, CW_CNT = 128, CW_BAR = 4096;

constexpr int RING_BYTES = 143360, MISC_OFF = RING_BYTES, LDS_BYTES = 147456;

typedef unsigned u32x2 __attribute__((ext_vector_type(2)));
__device__ __forceinline__ float bf2f(unsigned short b) { return __uint_as_float((unsigned)b << 16); }
__device__ __forceinline__ float bflo(unsigned u) { return __uint_as_float(u << 16); }
__device__ __forceinline__ float bfhi(unsigned u) { return __uint_as_float(u & 0xffff0000u); }
__device__ __forceinline__ float sigm(float x) { return __builtin_amdgcn_rcpf(1.f + __expf(-x)); }
__device__ __forceinline__ float silu(float x) { return x * __builtin_amdgcn_rcpf(1.f + __expf(-x)); }
__device__ __forceinline__ float wave_sum(float v) {
#pragma unroll
    for (int o = 1; o < 64; o <<= 1) v += __shfl_xor(v, o);
    return v;
}
__device__ __forceinline__ void st_bf4(bf16* p, f32x4 v) { u32x2 w; w.x = pk2(v[0], v[1]); w.y = pk2(v[2], v[3]); *(GAS u32x2*)p = w; }
__device__ __forceinline__ f32x4 ld_bf4(const bf16* p) { const u32x2 w = *(const GAS u32x2*)p; return (f32x4){bflo(w.x), bfhi(w.x), bflo(w.y), bfhi(w.y)}; }
__device__ __forceinline__ float add_x16(float s) { return s + __int_as_float(__builtin_amdgcn_ds_swizzle(__float_as_int(s), 0x401F)); }
__device__ __forceinline__ float add_x32(float s) { const auto rr = __builtin_amdgcn_permlane32_swap(__float_as_uint(s), __float_as_uint(s), false, false); return __uint_as_float(rr[0]) + __uint_as_float(rr[1]); }
__device__ __forceinline__ int row_tok(int row, int& b) { b = (int)(((float)row + 0.5f) * (1.0f / (float)LP)); return row - b * LP - PADF; }

using pg8::Unit;
typedef float f32x2_t __attribute__((ext_vector_type(2)));
typedef __bf16 bf16x2_t __attribute__((ext_vector_type(2)));
__device__ __forceinline__ unsigned cvtpk(float lo, float hi) { f32x2_t v = {lo, hi}; bf16x2_t b = __builtin_convertvector(v, bf16x2_t); return __builtin_bit_cast(unsigned, b); }
__device__ __forceinline__ void st_bf8(bf16* p, f32x4 a, f32x4 b) { *(GAS v4u*)p = (v4u){cvtpk(a[0], a[1]), cvtpk(a[2], a[3]), cvtpk(b[0], b[1]), cvtpk(b[2], b[3])}; }
__device__ __forceinline__ void ld_bf8(const bf16* p, f32x4& a, f32x4& b) { const v4u w = *(const GAS v4u*)p; a = (f32x4){bflo(w.x), bfhi(w.x), bflo(w.y), bfhi(w.y)}; b = (f32x4){bflo(w.z), bfhi(w.z), bflo(w.w), bfhi(w.w)}; }
#define EPI_ROWS(ai, m) (u.pm * 128 + (ai) * 128 + wr * 64 + (m) * 16 + fr)
#define EPI_C8(bj) ((bj) * 128 + wc * 32 + fq * 8)
#define EPI_LANE unsigned on_ = ~0u; asm volatile("" : "+s"(on_)); const int ln_ = (int)__builtin_amdgcn_mbcnt_hi(on_, __builtin_amdgcn_mbcnt_lo(on_, 0u)); const int fr = ln_ & 15, fq = ln_ >> 4; (void)fr_; (void)fq_;
#define EPI_SUMSQ(v) (((v)[0] * (v)[0] + (v)[1] * (v)[1]) + ((v)[2] * (v)[2] + (v)[3] * (v)[3]))

struct EpiInA {
    static constexpr bool PERM = true, AFTER_DRAIN = false;
    bf16 *CQ, *CKV, *XBC; float *KRF, *DT, *SSQ, *SSKV;
    __device__ __forceinline__ void operator()(const f32x4 (&acc)[2][2][4][2], const Unit& u, int wr, int wc, int fr_, int fq_) const {
        EPI_LANE
        const int pn = u.pn;
        if (pn == 0) {
#pragma unroll
            for (int ai = 0; ai < 2; ++ai)
#pragma unroll
                for (int m = 0; m < 4; ++m) { const int row = EPI_ROWS(ai, m); float s = 0.f;
#pragma unroll
                    for (int bj = 0; bj < 2; ++bj) { st_bf8(CQ + (size_t)row * 256 + EPI_C8(bj), acc[ai][bj][m][0], acc[ai][bj][m][1]); s += EPI_SUMSQ(acc[ai][bj][m][0]) + EPI_SUMSQ(acc[ai][bj][m][1]); }
                    s = add_x16(s); s = add_x32(s);
                    if (fq == 0) SSQ[(size_t)row * 4 + wc] = s; asm volatile("" ::: "memory"); }
        } else if (pn == 1) {
#pragma unroll
            for (int ai = 0; ai < 2; ++ai)
#pragma unroll
                for (int m = 0; m < 4; ++m) { const int row = EPI_ROWS(ai, m);
                    st_bf8(CKV + (size_t)row * 128 + wc * 32 + fq * 8, acc[ai][0][m][0], acc[ai][0][m][1]);
                    float s = EPI_SUMSQ(acc[ai][0][m][0]) + EPI_SUMSQ(acc[ai][0][m][1]);
                    s = add_x16(s); s = add_x32(s);
                    if (fq == 0) SSKV[(size_t)row * 4 + wc] = s;
                    if (wc == 0) { float* kp = KRF + (size_t)row * 32 + fq * 8; *(f32x4*)kp = acc[ai][1][m][0]; *(f32x4*)(kp + 4) = acc[ai][1][m][1]; }
                    else if (wc == 1 && fq < 2) { float* dp = DT + (size_t)row * 16 + fq * 8; *(f32x4*)dp = acc[ai][1][m][0]; *(f32x4*)(dp + 4) = acc[ai][1][m][1]; }
                    asm volatile("" ::: "memory"); }
        } else {
            const int cb = (pn - 2) * 256;
#pragma unroll
            for (int ai = 0; ai < 2; ++ai)
#pragma unroll
                for (int m = 0; m < 4; ++m) { const int row = EPI_ROWS(ai, m);
#pragma unroll
                    for (int bj = 0; bj < 2; ++bj) st_bf8(XBC + (size_t)row * CONVD + cb + EPI_C8(bj), acc[ai][bj][m][0], acc[ai][bj][m][1]); }
        }
    }
};

struct EpiQ {
    static constexpr bool PERM = true, AFTER_DRAIN = false;
    bf16 *Qn, *Qr; const float *SSQ, *CS;
    __device__ __forceinline__ void operator()(const f32x4 (&acc)[2][2][4][2], const Unit& u, int wr, int wc, int fr_, int fq_) const {
        EPI_LANE
        const int pn = u.pn;
#pragma unroll
        for (int ai = 0; ai < 2; ++ai)
#pragma unroll
            for (int m = 0; m < 4; ++m) { const int row = EPI_ROWS(ai, m);
                const f32x4 p = *(const f32x4*)(SSQ + (size_t)row * 4); const float rs = rsqrtf(((p[0] + p[1]) + (p[2] + p[3])) * (1.f / 256.f) + EPS);
                if (pn < 4) {
#pragma unroll
                    for (int bj = 0; bj < 2; ++bj) st_bf8(Qn + (size_t)row * 1024 + pn * 256 + EPI_C8(bj), acc[ai][bj][m][0] * rs, acc[ai][bj][m][1] * rs);
                } else {
                    int b; const int tok = row_tok(row, b);
                    const int jj = (fq & 1) * 8; const float sg = fq < 2 ? -1.f : 1.f;
                    f32x4 c0 = (f32x4){0.f, 0.f, 0.f, 0.f}, c1 = c0, s0 = c0, s1 = c0;
                    if (tok >= 0) { const float* cs = CS + (size_t)tok * 32 + jj; c0 = *(const f32x4*)cs; c1 = *(const f32x4*)(cs + 4); s0 = *(const f32x4*)(cs + 16) * sg; s1 = *(const f32x4*)(cs + 20) * sg; }
                    const int paddr = (ln_ ^ 32) << 2;
#pragma unroll
                    for (int bj = 0; bj < 2; ++bj) { const f32x4 x0 = acc[ai][bj][m][0] * rs, x1 = acc[ai][bj][m][1] * rs; f32x4 y0, y1;
#pragma unroll
                        for (int i = 0; i < 4; ++i) { y0[i] = __int_as_float(__builtin_amdgcn_ds_bpermute(paddr, __float_as_int(x0[i]))); y1[i] = __int_as_float(__builtin_amdgcn_ds_bpermute(paddr, __float_as_int(x1[i]))); }
                        st_bf8(Qr + (size_t)row * 512 + (pn - 4) * 256 + EPI_C8(bj), x0 * c0 + y0 * s0, x1 * c1 + y1 * s1); }
                } asm volatile("" ::: "memory"); }
    }
};
struct EpiKV {
    static constexpr bool PERM = true, AFTER_DRAIN = false;
    bf16* KV; const float* SSKV;
    __device__ __forceinline__ void operator()(const f32x4 (&acc)[2][2][4][2], const Unit& u, int wr, int wc, int fr_, int fq_) const {
        EPI_LANE
        float rs[8];
#pragma unroll
        for (int i = 0; i < 8; ++i) { const f32x4 p = *(const f32x4*)(SSKV + (size_t)EPI_ROWS(i >> 2, i & 3) * 4); rs[i] = rsqrtf(((p[0] + p[1]) + (p[2] + p[3])) * (1.f / 128.f) + EPS); }
#pragma unroll
        for (int ai = 0; ai < 2; ++ai)
#pragma unroll
            for (int m = 0; m < 4; ++m) { const int row = EPI_ROWS(ai, m); const float r1 = rs[ai * 4 + m];
#pragma unroll
                for (int bj = 0; bj < 2; ++bj) st_bf8(KV + (size_t)row * 2048 + u.pn * 256 + EPI_C8(bj), acc[ai][bj][m][0] * r1, acc[ai][bj][m][1] * r1); }
    }
};
struct EpiZG {
    static constexpr bool PERM = true, AFTER_DRAIN = false;
    bf16 *Z, *SA, *SS;
    __device__ __forceinline__ void operator()(const f32x4 (&acc)[2][2][4][2], const Unit& u, int wr, int wc, int fr_, int fq_) const {
        EPI_LANE
        const int pn = u.pn;
#pragma unroll
        for (int ai = 0; ai < 2; ++ai)
#pragma unroll
            for (int m = 0; m < 4; ++m) { const int row = EPI_ROWS(ai, m);
#pragma unroll
                for (int bj = 0; bj < 2; ++bj) { const f32x4 z0 = acc[ai][bj][m][0], z1 = acc[ai][bj][m][1]; const int c8 = EPI_C8(bj);
                    if (pn < 4) st_bf8(Z + (size_t)row * 1024 + pn * 256 + c8, (f32x4){silu(z0[0]), silu(z0[1]), silu(z0[2]), silu(z0[3])}, (f32x4){silu(z1[0]), silu(z1[1]), silu(z1[2]), silu(z1[3])});
                    else { bf16* gp = (pn < 8 ? SA + (size_t)row * 1024 + (pn - 4) * 256 : SS + (size_t)row * 1024 + (pn - 8) * 256) + c8;
                        st_bf8(gp, (f32x4){sigm(z0[0]), sigm(z0[1]), sigm(z0[2]), sigm(z0[3])}, (f32x4){sigm(z1[0]), sigm(z1[1]), sigm(z1[2]), sigm(z1[3])}); } } }
    }
};
template <int SECOND> struct EpiBr {
    static constexpr bool PERM = true, AFTER_DRAIN = false;
    bf16* MRG; const bf16* G;
    __device__ __forceinline__ void operator()(const f32x4 (&acc)[2][2][4][2], const Unit& u, int wr, int wc, int fr_, int fq_) const {
        EPI_LANE
#pragma unroll
        for (int ai = 0; ai < 2; ++ai)
#pragma unroll
            for (int m = 0; m < 4; ++m) { const int row = EPI_ROWS(ai, m);
#pragma unroll
                for (int bj = 0; bj < 2; ++bj) { const size_t o = (size_t)row * 1024 + u.pn * 256 + EPI_C8(bj); f32x4 g0, g1; ld_bf8(G + o, g0, g1);
                    f32x4 v0 = g0 * acc[ai][bj][m][0], v1 = g1 * acc[ai][bj][m][1];
                    if (SECOND) { f32x4 m0, m1; ld_bf8(MRG + o, m0, m1); v0 += m0; v1 += m1; }
                    st_bf8(MRG + o, v0, v1); } }
    }
};
struct EpiOut {
    static constexpr bool PERM = true, AFTER_DRAIN = false;
    bf16* DL;
    __device__ __forceinline__ void operator()(const f32x4 (&acc)[2][2][4][2], const Unit& u, int wr, int wc, int fr_, int fq_) const {
        EPI_LANE
#pragma unroll
        for (int ai = 0; ai < 2; ++ai)
#pragma unroll
            for (int m = 0; m < 4; ++m) { const int row = EPI_ROWS(ai, m);
#pragma unroll
                for (int bj = 0; bj < 2; ++bj) st_bf8(DL + (size_t)row * 1024 + u.pn * 256 + EPI_C8(bj), acc[ai][bj][m][0], acc[ai][bj][m][1]); }
    }
};
struct EpiGU {
    static constexpr bool PERM = true, AFTER_DRAIN = false;
    bf16* HM;
    __device__ __forceinline__ void operator()(const f32x4 (&acc)[2][2][4][2], const Unit& u, int wr, int wc, int fr_, int fq_) const {
        EPI_LANE
        const int j = u.pn & 1;
#pragma unroll
        for (int ai = 0; ai < 2; ++ai)
#pragma unroll
            for (int m = 0; m < 4; ++m) { const int row = EPI_ROWS(ai, m);
                const f32x4 g0 = acc[ai][0][m][0], g1 = acc[ai][0][m][1], u0 = acc[ai][1][m][0], u1 = acc[ai][1][m][1];
                st_bf8(HM + (size_t)row * 256 + j * 128 + wc * 32 + fq * 8, (f32x4){silu(g0[0]) * u0[0], silu(g0[1]) * u0[1], silu(g0[2]) * u0[2], silu(g0[3]) * u0[3]},
                       (f32x4){silu(g1[0]) * u1[0], silu(g1[1]) * u1[1], silu(g1[2]) * u1[2], silu(g1[3]) * u1[3]}); }
    }
};
struct EpiDown {
    static constexpr bool PERM = true, AFTER_DRAIN = false;
    bf16* YP; const int* PROW; const float* TOKW;
    __device__ __forceinline__ void operator()(const f32x4 (&acc)[2][2][4][2], const Unit& u, int wr, int wc, int fr_, int fq_) const {
        EPI_LANE
        const int j = u.pn & 3;
        int code[8];
#pragma unroll
        for (int i = 0; i < 8; ++i) code[i] = PROW[EPI_ROWS(i >> 2, i & 3)];
#pragma unroll
        for (int ai = 0; ai < 2; ++ai) { float w[4];
#pragma unroll
            for (int m = 0; m < 4; ++m) w[m] = TOKW[code[ai * 4 + m] < 0 ? 0 : code[ai * 4 + m]];
#pragma unroll
            for (int m = 0; m < 4; ++m) { const int cd = code[ai * 4 + m];
                if (cd >= 0) { const float ww = w[m]; bf16* dst = YP + ((size_t)(cd & 1) * MROWS + (cd >> 1)) * 1024 + j * 256;
#pragma unroll
                    for (int bj = 0; bj < 2; ++bj) st_bf8(dst + EPI_C8(bj), acc[ai][bj][m][0] * ww, acc[ai][bj][m][1] * ww); } } }
    }
};
struct MoeOrder {
    const LAS int* ost;
    int ncol, G, c;
    __device__ __forceinline__ bool next(int i, Unit& u) const {
        const int L = i * G + c, ntile = __builtin_amdgcn_readfirstlane(ost[NEXP] >> 8);
        if (L >= ntile * ncol) return false;
        const int rt = L / ncol, j = L - rt * ncol; int e = 0;
        for (int k = 1; k < NEXP; ++k) e += ((ost[k] >> 8) <= rt) ? 1 : 0;
        u.pm = __builtin_amdgcn_readfirstlane(2 * rt); u.pn = __builtin_amdgcn_readfirstlane(e * ncol + j); return true;
    }
    __device__ __forceinline__ void a_ready(const Unit&) const {}
    __device__ __forceinline__ void done(const Unit&) const {}
};

struct StdOrder {
    pg8::StaticOrder so;
    __device__ __forceinline__ void init(int M, int N, int G, int c) { so.init(M, N, G, c); }
    __device__ __forceinline__ bool next(int i, Unit& u) const { if (!so.next(i, u)) return false; u.pm *= 2; return true; }
    __device__ __forceinline__ void a_ready(const Unit&) const {}
    __device__ __forceinline__ void done(const Unit&) const {}
};
struct TokOrder {
    pg8::StaticOrder so;
    __device__ __forceinline__ void init(int N, int G, int c) { so.init(NB * SEQ, N, G, c); }
    __device__ __forceinline__ bool next(int i, Unit& u) const { if (!so.next(i, u)) return false; u.pm = 33 * (u.pm >> 4) + 1 + 2 * (u.pm & 15); return true; }
    __device__ __forceinline__ void a_ready(const Unit&) const {}
    __device__ __forceinline__ void done(const Unit&) const {}
};

__device__ __forceinline__ void tr_item(const float* __restrict__ W, int ldw, int sc0, int nvalid, int k0, const float* __restrict__ ks, float mul, bf16* WT, int K, int dn0, LAS float* scr, int lane) {
    (void)scr; const int n = lane & 31, kh = lane >> 5; const bool ok = n < nvalid;
    const float* src = W + (size_t)(k0 + 32 * kh) * ldw + sc0 + n; bf16* dst = WT + (size_t)(dn0 + n) * K + k0 + 32 * kh;
    float v[32];
#pragma unroll
    for (int j = 0; j < 32; ++j) v[j] = ok ? src[(size_t)j * ldw] : 0.f;
    if (ks) {
#pragma unroll
        for (int j = 0; j < 32; ++j) v[j] *= ks[k0 + 32 * kh + j]; }
#pragma unroll
    for (int kb = 0; kb < 4; ++kb) *(v4u*)(dst + 8 * kb) = (v4u){cvtpk(v[8 * kb] * mul, v[8 * kb + 1] * mul), cvtpk(v[8 * kb + 2] * mul, v[8 * kb + 3] * mul), cvtpk(v[8 * kb + 4] * mul, v[8 * kb + 5] * mul), cvtpk(v[8 * kb + 6] * mul, v[8 * kb + 7] * mul)};
}

struct In {
    const float *x, *meta, *norm_mix, *w_in, *q_norm, *w_uq, *kv_norm, *w_ukv, *conv_w, *conv_b, *dt_bias, *a_log, *d_skip, *ssm_norm, *w_ba, *w_bs, *w_out, *norm_ffn,
                *w_group, *b_group, *w_expert, *b_expert, *w_gate, *w_up, *w_down, *norm_final;
};

template <int PARTS = 7> __device__ __forceinline__ void p0_prologue(const In& I, unsigned char* ws, LAS unsigned char* lds, int gw, int NGW, int wave, int lane) {
    LAS float* scr = (LAS float*)(lds + wave * 16384);
    bf16 *WinA = (bf16*)(ws + WS_WINA), *WinB = (bf16*)(ws + WS_WINB), *Wuq = (bf16*)(ws + WS_WUQ), *Wukv = (bf16*)(ws + WS_WUKV), *Wba = (bf16*)(ws + WS_WBA), *Wbs = (bf16*)(ws + WS_WBS),
         *Wout = (bf16*)(ws + WS_WOUT), *Wgu = (bf16*)(ws + WS_WGU), *Wd = (bf16*)(ws + WS_WD);
    constexpr int I_A = 16 * 56, I_B = 16 * 96, I_UQ = 4 * 48, I_UKV = 2 * 64, I_SQ = 16 * 32, I_GU = 16 * 512, I_D = 4 * 1024;
    constexpr int NIT = I_A + I_B + I_UQ + I_UKV + 3 * I_SQ + I_GU + I_D;
    if (PARTS & 1) for (int it = gw; it < NIT; it += NGW) {
        int r = it;
        if (r < I_A) { const int kb = r / 56, n0 = (r % 56) * 32; int sc0 = 0, nv = 32;
            if (n0 < 416) sc0 = n0; else if (n0 == 416) { sc0 = 2720; nv = 16; } else if (n0 < 512) { sc0 = 0; nv = 0; } else sc0 = 1440 + (n0 - 512);
            tr_item(I.w_in, 4784, sc0, nv, kb * 64, nullptr, 1.f, WinA, 1024, n0, scr, lane); continue; }
        r -= I_A;
        if (r < I_B) { const int kb = r / 96, n0 = (r % 96) * 32; const int sc0 = n0 < 1024 ? 416 + n0 : (n0 < 2048 ? 2736 + (n0 - 1024) : 3760 + (n0 - 2048));
            tr_item(I.w_in, 4784, sc0, 32, kb * 64, nullptr, 1.f, WinB, 1024, n0, scr, lane); continue; }
        r -= I_B;
        if (r < I_UQ) { const int kb = r / 48, n0 = (r % 48) * 32; const int sc0 = n0 < 1024 ? 96 * (n0 / 64) + (n0 % 64) : 96 * ((n0 - 1024) / 32) + 64;
            tr_item(I.w_uq, 1536, sc0, 32, kb * 64, I.q_norm, QSCALE, Wuq, 256, n0, scr, lane); continue; }
        r -= I_UQ;
        if (r < I_UKV) { const int kb = r / 64, n0 = (r % 64) * 32; tr_item(I.w_ukv, 2048, n0, 32, kb * 64, I.kv_norm, 1.f, Wukv, 128, n0, scr, lane); continue; }
        r -= I_UKV;
        if (r < I_SQ) { const int kb = r / 32, n0 = (r % 32) * 32; tr_item(I.w_ba, 1024, n0, 32, kb * 64, nullptr, 1.f, Wba, 1024, n0, scr, lane); continue; }
        r -= I_SQ;
        if (r < I_SQ) { const int kb = r / 32, n0 = (r % 32) * 32; tr_item(I.w_bs, 1024, n0, 32, kb * 64, I.ssm_norm, 1.f, Wbs, 1024, n0, scr, lane); continue; }
        r -= I_SQ;
        if (r < I_SQ) { const int kb = r / 32, n0 = (r % 32) * 32; tr_item(I.w_out, 1024, n0, 32, kb * 64, nullptr, 1.f, Wout, 1024, n0, scr, lane); continue; }
        r -= I_SQ;
        if (r < I_GU) { const int kb = r / 512, n0 = (r % 512) * 32; const int e = n0 / 512, rr = n0 % 512, j = rr / 256, half = (rr % 256) / 128, c = rr % 128;
            const float* W = (half ? I.w_up : I.w_gate) + (size_t)e * 1024 * 256;
            tr_item(W, 256, 128 * j + c, 32, kb * 64, nullptr, 1.f, Wgu, 1024, n0, scr, lane); continue; }
        r -= I_GU;
        { const int kb = r / 1024, n0 = (r % 1024) * 32; const int e = n0 / 1024; const float* W = I.w_down + (size_t)e * 256 * 1024;
            tr_item(W, 1024, n0 % 1024, 32, kb * 64, nullptr, 1.f, Wd, 256, n0, scr, lane); }
    }
    float* CS = (float*)(ws + WS_CS);
    if (PARTS & 2) for (int idx = gw * 64 + lane; idx < LTOK * 16; idx += NGW * 64) { const int pos = idx >> 4, j = idx & 15;
        const float inv = exp2f(-(float)j * (13.287712379549449f / 16.f)); const float ang = (float)pos * inv;
        const double a = (double)ang; const double kk = rint(a * 0.15915494309189535); const float rr = (float)(a - kk * 6.283185307179586);
        CS[pos * 32 + j] = __cosf(rr); CS[pos * 32 + 16 + j] = __sinf(rr); }
    bf16* XN = (bf16*)(ws + WS_XN);
    f32x4 gm[4];
#pragma unroll
    for (int j = 0; j < 4; ++j) gm[j] = ((const f32x4*)I.norm_mix)[lane + 64 * j];
    if (PARTS & 4) for (int row0 = gw; row0 < MROWS; row0 += 2 * NGW) {
        const int row1 = row0 + NGW; const bool has1 = row1 < MROWS;
        int b0, b1; const int tok0 = row_tok(row0, b0), tok1 = has1 ? row_tok(row1, b1) : -1;
        const float* s0 = tok0 < 0 ? nullptr : (tok0 < NMETA ? I.meta + (size_t)tok0 * DM : I.x + ((size_t)b0 * SEQ + (tok0 - NMETA)) * DM);
        const float* s1 = tok1 < 0 ? nullptr : (tok1 < NMETA ? I.meta + (size_t)tok1 * DM : I.x + ((size_t)b1 * SEQ + (tok1 - NMETA)) * DM);
        f32x4 v0[4], v1[4];
#pragma unroll
        for (int j = 0; j < 4; ++j) { v0[j] = s0 ? ((const f32x4*)s0)[lane + 64 * j] : (f32x4){0.f, 0.f, 0.f, 0.f}; v1[j] = s1 ? ((const f32x4*)s1)[lane + 64 * j] : (f32x4){0.f, 0.f, 0.f, 0.f}; }
#define XN_ROW(V, ROW) do { float s = 0.f; \
        _Pragma("unroll") for (int j = 0; j < 4; ++j) s += (V[j][0] * V[j][0] + V[j][1] * V[j][1]) + (V[j][2] * V[j][2] + V[j][3] * V[j][3]); \
        const float rs = rsqrtf(wave_sum(s) * (1.f / DM) + EPS); unsigned long long* o8 = (unsigned long long*)(XN + (size_t)(ROW) * DM) + lane; \
        _Pragma("unroll") for (int j = 0; j < 4; ++j) { const f32x4 t = V[j] * rs * gm[j]; o8[64 * j] = (unsigned long long)cvtpk(t[0], t[1]) | ((unsigned long long)cvtpk(t[2], t[3]) << 32); } } while (0)
        XN_ROW(v0, row0);
        if (has1) XN_ROW(v1, row1);
#undef XN_ROW
    }
}

#define LDS_BARRIER() asm volatile("s_waitcnt lgkmcnt(0)\n\ts_barrier" ::: "memory")
typedef float f32x16 __attribute__((ext_vector_type(16)));
__device__ __forceinline__ v4u pack_rowpair(float a0, float a1, float a2, float a3, float c0, float c1, float c2, float c3) {
    const unsigned w0 = cvtpk(a0, a1), w1 = cvtpk(a2, a3), y0 = cvtpk(c0, c1), y1 = cvtpk(c2, c3);
    const auto s0 = __builtin_amdgcn_permlane32_swap(w0, y0, false, false); const auto s1 = __builtin_amdgcn_permlane32_swap(w1, y1, false, false);
    return (v4u){(unsigned)s0[0], (unsigned)s1[0], (unsigned)s0[1], (unsigned)s1[1]};
}
typedef short v4i16_t __attribute__((ext_vector_type(4)));
constexpr int AT_KP = 208, AT_VP = 144, AT_KB = 64 * AT_KP, AT_VB = 64 * AT_VP, AT_GRP = AT_KB + AT_VB, AT_BUF = 2 * AT_GRP;
__device__ __forceinline__ void attn_unit(int b, int hp, int j, const bf16* Qn, const bf16* Qr, const bf16* KV, const bf16* KR, bf16* Oout, unsigned omask, LAS unsigned char* lds, int tid) {
    asm volatile("" : "+v"(tid));
    const int lane = tid & 63, wave = __builtin_amdgcn_readfirstlane(tid >> 6), grp = wave >> 2, wq = wave & 3, r = lane & 31, hh = lane >> 5;
    const int h = 2 * hp + grp, tg = tid & 255;
    LAS unsigned char* Kt = lds + grp * AT_GRP; LAS unsigned char* Vt = Kt + AT_KB;
    const size_t rowb = (size_t)b * LP; const int R0 = 256 * j - 128 + 64 * wq; const int pqA = R0 + r, pqB = pqA + 32;
    const int last = 4 * j + 1, tmax = 4 * j + wq - 2;
    bf16x8 qfA[6], qfB[6];
    { const size_t ra = rowb + (pqA < 0 ? 0 : pqA), rb = rowb + (pqB < 0 ? 0 : pqB);
      const GAS bf16* qa = (const GAS bf16*)(Qn + ra * 1024 + h * 64 + 8 * hh); const GAS bf16* qb_ = (const GAS bf16*)(Qn + rb * 1024 + h * 64 + 8 * hh);
#pragma unroll
      for (int ks = 0; ks < 4; ++ks) { qfA[ks] = *(const GAS bf16x8*)(qa + 16 * ks); qfB[ks] = *(const GAS bf16x8*)(qb_ + 16 * ks); }
      const GAS bf16* pa = (const GAS bf16*)(Qr + ra * 512 + h * 32 + 8 * hh); const GAS bf16* pb_ = (const GAS bf16*)(Qr + rb * 512 + h * 32 + 8 * hh);
      qfA[4] = *(const GAS bf16x8*)pa; qfA[5] = *(const GAS bf16x8*)(pa + 16); qfB[4] = *(const GAS bf16x8*)pb_; qfB[5] = *(const GAS bf16x8*)(pb_ + 16); }
    const int k0 = tg >> 3, part = tg & 7;
    const __amdgpu_buffer_rsrc_t rkv = __builtin_amdgcn_make_buffer_rsrc((void*)(KV + rowb * 2048 + h * 128), 0, 0x7fffffff, 0x00020000);
    const __amdgpu_buffer_rsrc_t rkr = __builtin_amdgcn_make_buffer_rsrc((void*)(KR + rowb * 32), 0, 0x7fffffff, 0x00020000);
    const unsigned vok = (unsigned)(k0 * 4096 + part * 16), vor = (unsigned)((tg >> 2) * 64 + (tg & 3) * 16);
    LAS unsigned char* sk = Kt + k0 * AT_KP + part * 16; LAS unsigned char* sr = Kt + (tg >> 2) * AT_KP + 128 + (tg & 3) * 16; LAS unsigned char* sv = Vt + k0 * AT_VP + part * 16;
    v4u nk0, nk1, nr, nv0, nv1;
#define AT_LOAD(kt) do { const int so_ = (kt) * (64 * 4096), sr_ = (kt) * (64 * 64); \
        nk0 = __builtin_amdgcn_raw_buffer_load_b128(rkv, vok, so_, 0); nk1 = __builtin_amdgcn_raw_buffer_load_b128(rkv, vok, so_ + 32 * 4096, 0); nr = __builtin_amdgcn_raw_buffer_load_b128(rkr, vor, sr_, 0); \
        nv0 = __builtin_amdgcn_raw_buffer_load_b128(rkv, vok + 128, so_, 0); nv1 = __builtin_amdgcn_raw_buffer_load_b128(rkv, vok + 128, so_ + 32 * 4096, 0); } while (0)
#define AT_STORE(bo) do { *(LAS v4u*)(sk + (bo)) = nk0; *(LAS v4u*)(sk + (bo) + 32 * AT_KP) = nk1; *(LAS v4u*)(sr + (bo)) = nr; *(LAS v4u*)(sv + (bo)) = nv0; *(LAS v4u*)(sv + (bo) + 32 * AT_VP) = nv1; } while (0)
#define SBAR() __builtin_amdgcn_sched_barrier(0)
#define PIN(x) asm volatile("" : "+v"(x))
#define MF(a, b, c) __builtin_amdgcn_mfma_f32_32x32x16_bf16(a, b, c, 0, 0, 0)
#define MX3(a, b, c) __builtin_fmaxf(__builtin_fmaxf((a), (b)), (c))
#define RMAX16(p) ({ float a_ = MX3(p[0], p[1], p[2]), b_ = MX3(p[3], p[4], p[5]); a_ = MX3(a_, p[6], p[7]); b_ = MX3(b_, p[8], p[9]); a_ = MX3(a_, p[10], p[11]); b_ = MX3(b_, p[12], p[13]); a_ = MX3(a_, p[14], p[15]); __builtin_fmaxf(a_, b_); })
#define XMAX(m) ({ const auto rr_ = __builtin_amdgcn_permlane32_swap(__float_as_uint(m), __float_as_uint(m), false, false); __builtin_fmaxf(__uint_as_float(rr_[0]), __uint_as_float(rr_[1])); })
#define KRD(ks, hf) (*(const LAS bf16x8*)(ka + bo + (hf) * 32 * AT_KP + 32 * (ks)))
#define VRD(s, db) ({ const LAS unsigned char* vp_ = va + bo + (16 * (s)) * AT_VP + 64 * (db); const v4i16_t lo_ = __builtin_amdgcn_ds_read_tr16_b64_v4i16((LAS v4i16_t*)vp_), hi_ = __builtin_amdgcn_ds_read_tr16_b64_v4i16((LAS v4i16_t*)(vp_ + 8 * AT_VP)); \
        (bf16x8){lo_[0], lo_[1], lo_[2], lo_[3], hi_[0], hi_[1], hi_[2], hi_[3]}; })
#define MASKH(P, PQ, koff) do { const int lim_ = (PQ) - (64 * kt + 4 * hh + (koff));     \
        if (kt == 1) { const int lo_ = PADF - (64 + 4 * hh + (koff)); _Pragma("unroll") for (int i = 0; i < 16; ++i) { const int o_ = (i & 3) + 8 * (i >> 2); if (!(o_ >= lo_ && o_ <= lim_)) P[i] = -1e30f; } } \
        else { _Pragma("unroll") for (int i = 0; i < 16; ++i) { const int o_ = (i & 3) + 8 * (i >> 2); if (o_ > lim_) P[i] = -1e30f; } } } while (0)
#define EX4(P, i, M, S0, S1, WLO, WHI) do { P[i] = __builtin_amdgcn_exp2f(P[i] - M); P[i + 1] = __builtin_amdgcn_exp2f(P[i + 1] - M); P[i + 2] = __builtin_amdgcn_exp2f(P[i + 2] - M); P[i + 3] = __builtin_amdgcn_exp2f(P[i + 3] - M); \
        S0 += P[i]; S1 += P[i + 1]; S0 += P[i + 2]; S1 += P[i + 3]; WLO = cvtpk(P[i], P[i + 1]); WHI = cvtpk(P[i + 2], P[i + 3]); PIN(S0); PIN(S1); AT_DUMMY(P, i); } while (0)
#define BF8(w) __builtin_bit_cast(bf16x8, w)
#ifdef PRB_VALU
    float dmy0 = 0.f, dmy1 = 0.f;
#define AT_DUMMY(P, i) do { dmy0 += P[i]; dmy1 += P[i + 1]; dmy0 += P[i + 2]; dmy1 += P[i + 3]; PIN(dmy0); PIN(dmy1); } while (0)
#else
#define AT_DUMMY(P, i) do { } while (0)
#endif
    constexpr float AT_THR = 8.f;
    const f32x16 Z16 = {0.f, 0.f, 0.f, 0.f, 0.f, 0.f, 0.f, 0.f, 0.f, 0.f, 0.f, 0.f, 0.f, 0.f, 0.f, 0.f};
    f32x16 oA0, oA1, oB0, oB1;
#pragma unroll
    for (int i = 0; i < 16; ++i) { oA0[i] = 0.f; oA1[i] = 0.f; oB0[i] = 0.f; oB1[i] = 0.f; }
    float mA = -20000.f, lA = 0.f, mB = -20000.f, lB = 0.f;
    const LAS unsigned char* ka = Kt + r * AT_KP + 16 * hh;
    const LAS unsigned char* va = Vt + (4 * hh + ((lane & 15) >> 2)) * AT_VP + (16 * ((lane >> 4) & 1) + 4 * (lane & 3)) * 2;
    AT_LOAD(1);
    __syncthreads();
    AT_STORE(0);
    if (last > 1) AT_LOAD(2);
    int bo = 0;
    f32x16 pB1; v4u wA2, wA3; bf16x8 vf4, vf5, vf6, vf7; bool prev = false;
#define AT_S4() do { float sa_ = 0.f, sb_ = 0.f; v4u wB2, wB3; \
        oA0 = MF(vf4, BF8(wA2), oA0); EX4(pB1, 0, mB, sa_, sb_, wB2.x, wB2.y); SBAR(); \
        oA1 = MF(vf5, BF8(wA2), oA1); EX4(pB1, 4, mB, sa_, sb_, wB2.z, wB2.w); PIN(wB2); SBAR(); \
        oA0 = MF(vf6, BF8(wA3), oA0); EX4(pB1, 8, mB, sa_, sb_, wB3.x, wB3.y); SBAR(); \
        oA1 = MF(vf7, BF8(wA3), oA1); EX4(pB1, 12, mB, sa_, sb_, wB3.z, wB3.w); PIN(wB3); lB += sa_ + sb_; SBAR(); \
        oB0 = MF(vf4, BF8(wB2), oB0); oB1 = MF(vf5, BF8(wB2), oB1); oB0 = MF(vf6, BF8(wB3), oB0); oB1 = MF(vf7, BF8(wB3), oB1); SBAR(); } while (0)
#ifndef AT_ANTI
#define AT_ANTI 0
#endif
#if AT_ANTI
    if (grp) LDS_BARRIER();
#endif
    for (int kt = 1; kt <= last; ++kt) {
#ifdef PRB_ATTBAR
        const unsigned long long tb0_ = wall_clock64();
#endif
        LDS_BARRIER();
#ifdef PRB_ATTBAR
        if (lane == 0) (void)__hip_atomic_fetch_add((LAS unsigned*)(lds + MISC_OFF + 40), (unsigned)(wall_clock64() - tb0_), __ATOMIC_RELAXED, __HIP_MEMORY_SCOPE_WORKGROUP);
#endif
        if (kt < last) AT_STORE(bo ^ AT_BUF);
        const bool cur = kt <= tmax;
        bf16x8 ka0, ka1, ka2, ka3;
        if (cur) { ka0 = KRD(0, 0); ka1 = KRD(1, 0); }
        SBAR();
#ifdef PRB_LDS
        { bf16x8 d0_ = KRD(0, 1), d1_ = KRD(1, 1), d2_ = KRD(2, 1), d3_ = KRD(3, 1), d4_ = KRD(4, 1), d5_ = KRD(5, 1); PIN(d0_); PIN(d1_); PIN(d2_); PIN(d3_); PIN(d4_); PIN(d5_); SBAR(); }
#endif
        if (prev) AT_S4();
        prev = cur;
        if (kt + 1 < last) AT_LOAD(kt + 2);
        if (cur) {
            const bool dg = (kt == 1 || 64 * kt + 63 > R0);
            f32x16 pA0, pB0, pA1; bf16x8 kq0, kq1, kq2, kq3, kq4, kq5;
            ka2 = KRD(2, 0); ka3 = KRD(3, 0);
            pA0 = MF(ka0, qfA[0], Z16); pB0 = MF(ka0, qfB[0], Z16); ka0 = KRD(4, 0);
            pA0 = MF(ka1, qfA[1], pA0); pB0 = MF(ka1, qfB[1], pB0); ka1 = KRD(5, 0);
            pA0 = MF(ka2, qfA[2], pA0); pB0 = MF(ka2, qfB[2], pB0); kq0 = KRD(0, 1);
            pA0 = MF(ka3, qfA[3], pA0); pB0 = MF(ka3, qfB[3], pB0); kq1 = KRD(1, 1);
            pA0 = MF(ka0, qfA[4], pA0); pB0 = MF(ka0, qfB[4], pB0); kq2 = KRD(2, 1);
            pA0 = MF(ka1, qfA[5], pA0); pB0 = MF(ka1, qfB[5], pB0); kq3 = KRD(3, 1);
            SBAR();
#if AT_ANTI
            LDS_BARRIER();
#endif
            if (dg) { MASKH(pA0, pqA, 0); MASKH(pB0, pqB, 0); }
            float tA, tB, sa = 0.f, sb = 0.f;
            v4u wA0, wA1, wB0, wB1; bf16x8 vf0, vf1, vf2, vf3;
            pA1 = MF(kq0, qfA[0], Z16); tA = RMAX16(pA0); PIN(tA); SBAR();
            pB1 = MF(kq0, qfB[0], Z16); tB = RMAX16(pB0); PIN(tB); SBAR();
            pA1 = MF(kq1, qfA[1], pA1); tA = XMAX(tA); tB = XMAX(tB); kq4 = KRD(4, 1); PIN(tA); PIN(tB); SBAR();
            pB1 = MF(kq1, qfB[1], pB1); kq5 = KRD(5, 1);
            if (__builtin_amdgcn_ballot_w64((tA > mA + AT_THR) || (tB > mB + AT_THR)) != 0ull) {
                const float nA = __builtin_fmaxf(mA, tA), aA = __builtin_amdgcn_exp2f(mA - nA), nB = __builtin_fmaxf(mB, tB), aB = __builtin_amdgcn_exp2f(mB - nB);
                mA = nA; mB = nB; lA *= aA; lB *= aB;
#pragma unroll
                for (int i = 0; i < 16; ++i) { oA0[i] *= aA; oA1[i] *= aA; oB0[i] *= aB; oB1[i] *= aB; } }
            SBAR();
            pA1 = MF(kq2, qfA[2], pA1); EX4(pA0, 0, mA, sa, sb, wA0.x, wA0.y); SBAR();
            pB1 = MF(kq2, qfB[2], pB1); EX4(pA0, 4, mA, sa, sb, wA0.z, wA0.w); PIN(wA0); SBAR();
            pA1 = MF(kq3, qfA[3], pA1); EX4(pA0, 8, mA, sa, sb, wA1.x, wA1.y); SBAR();
            pB1 = MF(kq3, qfB[3], pB1); EX4(pA0, 12, mA, sa, sb, wA1.z, wA1.w); PIN(wA1); lA += sa + sb; sa = 0.f; sb = 0.f; PIN(lA); SBAR();
            pA1 = MF(kq4, qfA[4], pA1); EX4(pB0, 0, mB, sa, sb, wB0.x, wB0.y); SBAR();
            pB1 = MF(kq4, qfB[4], pB1); EX4(pB0, 4, mB, sa, sb, wB0.z, wB0.w); PIN(wB0); SBAR();
            pA1 = MF(kq5, qfA[5], pA1); EX4(pB0, 8, mB, sa, sb, wB1.x, wB1.y); SBAR();
            pB1 = MF(kq5, qfB[5], pB1); EX4(pB0, 12, mB, sa, sb, wB1.z, wB1.w); PIN(wB1); vf0 = VRD(0, 0); lB += sa + sb; PIN(lB); SBAR();
            if (dg) { MASKH(pA1, pqA, 32); MASKH(pB1, pqB, 32); }
            sa = 0.f; sb = 0.f;
            float aA1 = 1.f, aB1 = 1.f; bool rs1;
            oA0 = MF(vf0, BF8(wA0), oA0); tA = RMAX16(pA1); vf1 = VRD(0, 1); PIN(tA); SBAR();
            oB0 = MF(vf0, BF8(wB0), oB0); tB = RMAX16(pB1); vf2 = VRD(1, 0); PIN(tB); SBAR();
            oA1 = MF(vf1, BF8(wA0), oA1); tA = XMAX(tA); tB = XMAX(tB); vf3 = VRD(1, 1); vf4 = VRD(2, 0); PIN(tA); PIN(tB); SBAR();
            oB1 = MF(vf1, BF8(wB0), oB1); vf5 = VRD(2, 1);
            rs1 = __builtin_amdgcn_ballot_w64((tA > mA + AT_THR) || (tB > mB + AT_THR)) != 0ull;
            if (rs1) { const float nA = __builtin_fmaxf(mA, tA), nB = __builtin_fmaxf(mB, tB); aA1 = __builtin_amdgcn_exp2f(mA - nA); aB1 = __builtin_amdgcn_exp2f(mB - nB); mA = nA; mB = nB; lA *= aA1; lB *= aB1; }
            SBAR();
#ifdef PRB_MFMA
            pA0 = MF(vf2, BF8(wA1), pA0); PIN(pA0); SBAR(); pA0 = MF(vf2, BF8(wB1), pA0); PIN(pA0); SBAR(); pA0 = MF(vf3, BF8(wA1), pA0); PIN(pA0); SBAR(); pA0 = MF(vf3, BF8(wB1), pA0); PIN(pA0); SBAR();
#endif
            oA0 = MF(vf2, BF8(wA1), oA0); EX4(pA1, 0, mA, sa, sb, wA2.x, wA2.y); vf6 = VRD(3, 0); SBAR();
            oB0 = MF(vf2, BF8(wB1), oB0); EX4(pA1, 4, mA, sa, sb, wA2.z, wA2.w); PIN(wA2); vf7 = VRD(3, 1); SBAR();
            oA1 = MF(vf3, BF8(wA1), oA1); EX4(pA1, 8, mA, sa, sb, wA3.x, wA3.y); SBAR();
            oB1 = MF(vf3, BF8(wB1), oB1); EX4(pA1, 12, mA, sa, sb, wA3.z, wA3.w); PIN(wA3); lA += sa + sb; sa = 0.f; sb = 0.f; PIN(lA); SBAR();
            if (rs1) {
#pragma unroll
                for (int i = 0; i < 16; ++i) { oA0[i] *= aA1; oA1[i] *= aA1; oB0[i] *= aB1; oB1[i] *= aB1; } }
        }
#if AT_ANTI
        else LDS_BARRIER();
#endif
        bo ^= AT_BUF;
    }
    if (prev) AT_S4();
#undef AT_S4
#if AT_ANTI
    if (!grp) LDS_BARRIER();
#endif
#undef SBAR
#undef PIN
#undef MF
#undef MX3
#undef RMAX16
#undef XMAX
#undef KRD
#undef VRD
#undef MASKH
#undef EX4
#undef BF8
#undef AT_STORE
#undef AT_LOAD
    const int ln2 = (int)__builtin_amdgcn_mbcnt_hi(~0u, __builtin_amdgcn_mbcnt_lo(~0u, 0u)), hh2 = ln2 >> 5, pqA2 = R0 + (ln2 & 31), pqB2 = pqA2 + 32;
    { const auto ra_ = __builtin_amdgcn_permlane32_swap(__float_as_uint(lA), __float_as_uint(lA), false, false); lA = __uint_as_float(ra_[0]) + __uint_as_float(ra_[1]);
      const auto rb_ = __builtin_amdgcn_permlane32_swap(__float_as_uint(lB), __float_as_uint(lB), false, false); lB = __uint_as_float(rb_[0]) + __uint_as_float(rb_[1]); }
    const float iA = lA > 0.f ? 1.f / lA : 0.f, iB = lB > 0.f ? 1.f / lB : 0.f;
#define AT_OUT(O0, O1, INV, PQ) do { \
        const v4u q0 = pack_rowpair(O0[0] * INV, O0[1] * INV, O0[2] * INV, O0[3] * INV, O0[4] * INV, O0[5] * INV, O0[6] * INV, O0[7] * INV); \
        const v4u q1 = pack_rowpair(O0[8] * INV, O0[9] * INV, O0[10] * INV, O0[11] * INV, O0[12] * INV, O0[13] * INV, O0[14] * INV, O0[15] * INV); \
        const v4u q2 = pack_rowpair(O1[0] * INV, O1[1] * INV, O1[2] * INV, O1[3] * INV, O1[4] * INV, O1[5] * INV, O1[6] * INV, O1[7] * INV); \
        const v4u q3 = pack_rowpair(O1[8] * INV, O1[9] * INV, O1[10] * INV, O1[11] * INV, O1[12] * INV, O1[13] * INV, O1[14] * INV, O1[15] * INV); \
        if (PQ >= 0) { GAS v4u* op = (GAS v4u*)(Oout + (size_t)((unsigned)(rowb + PQ) & omask) * 1024 + h * 64 + 8 * hh2); op[0] = q0; op[2] = q1; op[4] = q2; op[6] = q3; } } while (0)
    AT_OUT(oA0, oA1, iA, pqA2);
    AT_OUT(oB0, oB1, iB, pqB2);
#undef AT_OUT
}

constexpr int SD_P = 144, SD_IMG = 128 * SD_P, SD_B = 0, SD_C = SD_IMG, SD_HD = 2 * SD_IMG, SD_HSZ = 2 * SD_IMG + 64 * SD_P + 2048;
constexpr int SD_XDT = 0, SD_XDD = SD_IMG, SD_S = 2 * SD_IMG, SD_SC = 2 * SD_IMG + 64 * SD_P;
static_assert(SD_HD + 2 * SD_HSZ <= RING_BYTES, "SSD LDS map");
__device__ __forceinline__ bf16x8 ssd_tr8(const LAS unsigned char* p) {
    const v4i16_t lo = __builtin_amdgcn_ds_read_tr16_b64_v4i16((LAS v4i16_t*)p), hi = __builtin_amdgcn_ds_read_tr16_b64_v4i16((LAS v4i16_t*)(p + 8 * SD_P));
    return (bf16x8){lo[0], lo[1], lo[2], lo[3], hi[0], hi[1], hi[2], hi[3]};
}
__device__ __forceinline__ void ssd_unit(int b, int hp, const In& I, const bf16* XBC, const float* DT, bf16* Y, LAS unsigned char* lds, int tid) {
    const int lane = tid & 63, wave = __builtin_amdgcn_readfirstlane(tid >> 6), r = lane & 31, hh = lane >> 5;
    const int hs = wave >> 2, lb = wave & 3, h = 2 * hp + hs, g = hp >> 2;
    const float Ah = -__expf(I.a_log[h]), Dh = I.d_skip[h];
    LAS unsigned char* HD = lds + SD_HD + hs * SD_HSZ;
    LAS float* SC = (LAS float*)(HD + SD_SC);
    const size_t rowb = (size_t)b * LP;
    const int cg = tid & 31, rg = tid >> 5;
    const int gcol = cg < 16 ? (2 * hp) * 64 + cg * 8 : (cg < 24 ? 1024 + g * 64 + (cg - 16) * 8 : 1152 + g * 64 + (cg - 24) * 8);
    float cw[4][8], cbias[8];
#pragma unroll
    for (int k = 0; k < 8; ++k) { cbias[k] = I.conv_b[gcol + k];
#pragma unroll
        for (int t = 0; t < 4; ++t) cw[t][k] = I.conv_w[t * CONVD + gcol + k]; }
    const GAS bf16* graw = (const GAS bf16*)(XBC + (rowb + 8 * rg - 3) * CONVD + gcol);
    LAS unsigned char* wdst = lds + (cg < 16 ? SD_HD + (cg >> 3) * SD_HSZ + SD_XDT : (cg < 24 ? SD_B : SD_C)) + (8 * rg) * SD_P + (cg & 7) * 16;
    LAS float* WSC = (LAS float*)(lds + SD_HD + ((cg >> 3) & 1) * SD_HSZ + SD_SC);
    v4u raw[11];
#define SD_LOAD(c) do { _Pragma("unroll") for (int i = 0; i < 11; ++i) raw[i] = *(const GAS v4u*)(graw + ((size_t)(c) * 128 + i) * CONVD); } while (0)
    SD_LOAD(0);
    f32x16 Sreg;
#pragma unroll
    for (int i = 0; i < 16; ++i) Sreg[i] = 0.f;
    const int l = 32 * lb + r, pt = lb & 1, nt = lb >> 1;
    const int q4 = (lane & 15) >> 2, pp = lane & 3, gg = (lane >> 4) & 1;
    const int troff = (4 * hh + q4) * SD_P + (16 * gg + 4 * pp) * 2;
    float dn0 = 0.f, dn1 = 0.f;
    const GAS float* DTg = (const GAS float*)DT;
    if (lb == 3) { const int l0 = 2 * lane; dn0 = (l0 >= PADF) ? DTg[(rowb + l0) * 16 + h] : 0.f; dn1 = (l0 + 1 >= PADF) ? DTg[(rowb + l0 + 1) * 16 + h] : 0.f; }
    for (int c = 0; c < NCHUNK; ++c) {
        LDS_BARRIER();
        if (lb == 3) {
            const int l0 = 2 * lane; const float d0 = dn0, d1 = dn1;
            if (c + 1 < NCHUNK) { const size_t rr = rowb + (size_t)(c + 1) * 128 + l0; dn0 = DTg[rr * 16 + h]; dn1 = DTg[(rr + 1) * 16 + h]; }
            const float a0 = d0 * Ah, a1 = d1 * Ah; float v = a0 + a1;
#pragma unroll
            for (int o = 1; o < 64; o <<= 1) { const float t = __shfl_up(v, o); if (lane >= o) v += t; }
            const float tot = __shfl(v, 63), acs1 = v, acs0 = v - a1;
            SC[l0] = d0; SC[l0 + 1] = d1; SC[128 + l0] = acs0; SC[129 + l0] = acs1; SC[256 + l0] = __expf(acs0); SC[257 + l0] = __expf(acs1); SC[384 + l0] = __expf(tot - acs0); SC[385 + l0] = __expf(tot - acs1);
        }
        {
#pragma unroll
            for (int i = 0; i < 16; ++i) *(LAS bf16*)(HD + SD_S + (32 * pt + (i & 3) + 8 * (i >> 2) + 4 * hh) * SD_P + (32 * nt + r) * 2) = (bf16)f2bf(Sreg[i]);
        }
        {
#pragma unroll
            for (int j = 0; j < 8; ++j) { const int ll = 8 * rg + j; const bool real = c * 128 + ll >= PADF; float v[8];
#pragma unroll
                for (int k = 0; k < 8; ++k) { float a = cbias[k];
#pragma unroll
                    for (int t = 0; t < 4; ++t) { const unsigned w = raw[j + t][k >> 1]; a += cw[t][k] * ((k & 1) ? bfhi(w) : bflo(w)); }
                    v[k] = real ? silu(a) : 0.f; }
                *(LAS v4u*)(wdst + j * SD_P) = (v4u){cvtpk(v[0], v[1]), cvtpk(v[2], v[3]), cvtpk(v[4], v[5]), cvtpk(v[6], v[7])}; }
        }
        LDS_BARRIER();
        if (cg < 16) {
#pragma unroll
            for (int j = 0; j < 8; ++j) { const int ll = 8 * rg + j; LAS unsigned char* d = wdst + j * SD_P; const v4u xw = *(const LAS v4u*)d; const float dt = WSC[ll], dd = dt * WSC[384 + ll];
                const float x0 = bflo(xw.x), x1 = bfhi(xw.x), x2 = bflo(xw.y), x3 = bfhi(xw.y), x4 = bflo(xw.z), x5 = bfhi(xw.z), x6 = bflo(xw.w), x7 = bfhi(xw.w);
                *(LAS v4u*)d = (v4u){cvtpk(x0 * dt, x1 * dt), cvtpk(x2 * dt, x3 * dt), cvtpk(x4 * dt, x5 * dt), cvtpk(x6 * dt, x7 * dt)};
                *(LAS v4u*)(d + SD_XDD) = (v4u){cvtpk(x0 * dd, x1 * dd), cvtpk(x2 * dd, x3 * dd), cvtpk(x4 * dd, x5 * dd), cvtpk(x6 * dd, x7 * dd)}; }
        }
        LDS_BARRIER();
        if (c + 1 < NCHUNK) SD_LOAD(c + 1);
        bf16x8 cf[4];
#pragma unroll
        for (int ks = 0; ks < 4; ++ks) cf[ks] = *(const LAS bf16x8*)(lds + SD_C + l * SD_P + (16 * ks + 8 * hh) * 2);
        f32x16 acc0, acc1;
#pragma unroll
        for (int i = 0; i < 16; ++i) { acc0[i] = 0.f; acc1[i] = 0.f; }
#pragma unroll
        for (int ks = 0; ks < 4; ++ks) { const LAS unsigned char* sp = HD + SD_S + r * SD_P + (16 * ks + 8 * hh) * 2;
            acc0 = __builtin_amdgcn_mfma_f32_32x32x16_bf16(*(const LAS bf16x8*)sp, cf[ks], acc0, 0, 0, 0); acc1 = __builtin_amdgcn_mfma_f32_32x32x16_bf16(*(const LAS bf16x8*)(sp + 32 * SD_P), cf[ks], acc1, 0, 0, 0); }
        { const float ea = SC[256 + l];
#pragma unroll
          for (int i = 0; i < 16; ++i) { acc0[i] *= ea; acc1[i] *= ea; } }
        const float acl = SC[128 + l];
#pragma unroll 1
        for (int sb = 0; sb <= lb; ++sb) {
            f32x16 X;
#pragma unroll
            for (int i = 0; i < 16; ++i) X[i] = 0.f;
#pragma unroll
            for (int ks = 0; ks < 4; ++ks) { const bf16x8 a = *(const LAS bf16x8*)(lds + SD_B + (32 * sb + r) * SD_P + (16 * ks + 8 * hh) * 2); X = __builtin_amdgcn_mfma_f32_32x32x16_bf16(a, cf[ks], X, 0, 0, 0); }
#pragma unroll
            for (int g4 = 0; g4 < 4; ++g4) { const int s0 = 32 * sb + 8 * g4 + 4 * hh; const f32x4 as4 = *(const LAS f32x4*)(SC + 128 + s0);
#pragma unroll
                for (int j = 0; j < 4; ++j) { const float f = (s0 + j <= l) ? __expf(acl - as4[j]) : 0.f; X[4 * g4 + j] *= f; } }
            v4u w0, w1;
            w0.x = cvtpk(X[0], X[1]); w0.y = cvtpk(X[2], X[3]); w0.z = cvtpk(X[4], X[5]); w0.w = cvtpk(X[6], X[7]);
            w1.x = cvtpk(X[8], X[9]); w1.y = cvtpk(X[10], X[11]); w1.z = cvtpk(X[12], X[13]); w1.w = cvtpk(X[14], X[15]);
            const LAS unsigned char* vp = HD + SD_XDT + (32 * sb) * SD_P + troff;
            acc0 = __builtin_amdgcn_mfma_f32_32x32x16_bf16(ssd_tr8(vp), __builtin_bit_cast(bf16x8, w0), acc0, 0, 0, 0);
            acc1 = __builtin_amdgcn_mfma_f32_32x32x16_bf16(ssd_tr8(vp + 64), __builtin_bit_cast(bf16x8, w0), acc1, 0, 0, 0);
            acc0 = __builtin_amdgcn_mfma_f32_32x32x16_bf16(ssd_tr8(vp + 16 * SD_P), __builtin_bit_cast(bf16x8, w1), acc0, 0, 0, 0);
            acc1 = __builtin_amdgcn_mfma_f32_32x32x16_bf16(ssd_tr8(vp + 16 * SD_P + 64), __builtin_bit_cast(bf16x8, w1), acc1, 0, 0, 0);
        }
        { const float dtl = SC[l], rdt = dtl > 0.f ? Dh * __builtin_amdgcn_rcpf(dtl) : 0.f;
          GAS v4u* yp = (GAS v4u*)(Y + (rowb + (size_t)c * 128 + l) * 1024 + h * 64 + 8 * hh); const LAS unsigned char* xp = HD + SD_XDT + l * SD_P + (4 * hh) * 2;
#pragma unroll
          for (int m = 0; m < 2; ++m) { const u32x2 xa = *(const LAS u32x2*)(xp + 32 * m), xc = *(const LAS u32x2*)(xp + 32 * m + 16), xb = *(const LAS u32x2*)(xp + 64 + 32 * m), xd = *(const LAS u32x2*)(xp + 64 + 32 * m + 16);
              yp[2 * m] = pack_rowpair(acc0[8 * m] + rdt * bflo(xa.x), acc0[8 * m + 1] + rdt * bfhi(xa.x), acc0[8 * m + 2] + rdt * bflo(xa.y), acc0[8 * m + 3] + rdt * bfhi(xa.y),
                                       acc0[8 * m + 4] + rdt * bflo(xc.x), acc0[8 * m + 5] + rdt * bfhi(xc.x), acc0[8 * m + 6] + rdt * bflo(xc.y), acc0[8 * m + 7] + rdt * bfhi(xc.y));
              yp[4 + 2 * m] = pack_rowpair(acc1[8 * m] + rdt * bflo(xb.x), acc1[8 * m + 1] + rdt * bfhi(xb.x), acc1[8 * m + 2] + rdt * bflo(xb.y), acc1[8 * m + 3] + rdt * bfhi(xb.y),
                                           acc1[8 * m + 4] + rdt * bflo(xd.x), acc1[8 * m + 5] + rdt * bfhi(xd.x), acc1[8 * m + 6] + rdt * bflo(xd.y), acc1[8 * m + 7] + rdt * bfhi(xd.y)); } }
        { const float cd = SC[256 + 127];
#pragma unroll
          for (int i = 0; i < 16; ++i) Sreg[i] *= cd;
#pragma unroll
          for (int ks = 0; ks < 8; ++ks) { const bf16x8 a = ssd_tr8(HD + SD_XDD + (16 * ks) * SD_P + (32 * pt) * 2 + troff), bb = ssd_tr8(lds + SD_B + (16 * ks) * SD_P + (32 * nt) * 2 + troff);
              Sreg = __builtin_amdgcn_mfma_f32_32x32x16_bf16(a, bb, Sreg, 0, 0, 0); } }
    }
#undef SD_LOAD
    __syncthreads();
}


__device__ __forceinline__ void p5_groupnorm(bf16* Y, const bf16* Z, int gw, int NGW, int lane) {
    for (int t = gw; t < NB * SEQ; t += 2 * NGW) {
        const int t2 = t + NGW; const bool has2 = t2 < NB * SEQ;
        const int row = (t >> 12) * LP + PADF + NMETA + (t & 4095), row2 = has2 ? (t2 >> 12) * LP + PADF + NMETA + (t2 & 4095) : row;
        v4u* p = (v4u*)(Y + (size_t)row * 1024) + 2 * lane; v4u* p2 = (v4u*)(Y + (size_t)row2 * 1024) + 2 * lane;
        const v4u* zq = (const v4u*)(Z + (size_t)row * 1024) + 2 * lane; const v4u* zq2 = (const v4u*)(Z + (size_t)row2 * 1024) + 2 * lane;
        const v4u a = p[0], c = p[1], a2 = p2[0], c2 = p2[1], za = zq[0], zc = zq[1], za2 = zq2[0], zc2 = zq2[1];
#define GN_ROW(A, C, ZA, ZC, P) do { float f[16]; \
        f[0] = bflo(A.x); f[1] = bfhi(A.x); f[2] = bflo(A.y); f[3] = bfhi(A.y); f[4] = bflo(A.z); f[5] = bfhi(A.z); f[6] = bflo(A.w); f[7] = bfhi(A.w); \
        f[8] = bflo(C.x); f[9] = bfhi(C.x); f[10] = bflo(C.y); f[11] = bfhi(C.y); f[12] = bflo(C.z); f[13] = bfhi(C.z); f[14] = bflo(C.w); f[15] = bfhi(C.w); \
        f[0] *= bflo(ZA.x); f[1] *= bfhi(ZA.x); f[2] *= bflo(ZA.y); f[3] *= bfhi(ZA.y); f[4] *= bflo(ZA.z); f[5] *= bfhi(ZA.z); f[6] *= bflo(ZA.w); f[7] *= bfhi(ZA.w); \
        f[8] *= bflo(ZC.x); f[9] *= bfhi(ZC.x); f[10] *= bflo(ZC.y); f[11] *= bfhi(ZC.y); f[12] *= bflo(ZC.z); f[13] *= bfhi(ZC.z); f[14] *= bflo(ZC.w); f[15] *= bfhi(ZC.w); \
        float s = 0.f; _Pragma("unroll") for (int i = 0; i < 16; ++i) s += f[i] * f[i]; \
        _Pragma("unroll") for (int o = 1; o < 32; o <<= 1) s += __shfl_xor(s, o); \
        const float rs = rsqrtf(s * (1.f / 512.f) + EPS); \
        P[0] = (v4u){cvtpk(f[0] * rs, f[1] * rs), cvtpk(f[2] * rs, f[3] * rs), cvtpk(f[4] * rs, f[5] * rs), cvtpk(f[6] * rs, f[7] * rs)}; \
        P[1] = (v4u){cvtpk(f[8] * rs, f[9] * rs), cvtpk(f[10] * rs, f[11] * rs), cvtpk(f[12] * rs, f[13] * rs), cvtpk(f[14] * rs, f[15] * rs)}; } while (0)
        GN_ROW(a, c, za, zc, p);
        if (has2) GN_ROW(a2, c2, za2, zc2, p2);
#undef GN_ROW
    }
}

__device__ __forceinline__ void p2_rowpass(const float* KRF, bf16* KR, float* DT, const float* CS, const float* dt_bias, int gtid, int nthr) {
    for (int idx = gtid; idx < MROWS * 16; idx += nthr) { const int row = idx >> 4, j = idx & 15; int b; const int tok = row_tok(row, b);
        float o1 = 0.f, o2 = 0.f, d = 0.f;
        if (tok >= 0) { const float x1 = KRF[(size_t)row * 32 + j], x2 = KRF[(size_t)row * 32 + 16 + j], c = CS[(size_t)tok * 32 + j], sn = CS[(size_t)tok * 32 + 16 + j];
            o1 = x1 * c - x2 * sn; o2 = x2 * c + x1 * sn;
            const float x = DT[idx] + dt_bias[j]; d = fmaxf(x, 0.f) + __logf(1.f + __expf(-fabsf(x))); }
        KR[(size_t)row * 32 + j] = (bf16)f2bf(o1); KR[(size_t)row * 32 + 16 + j] = (bf16)f2bf(o2); DT[idx] = d; }
}
constexpr int WE_P = 1028;
__device__ __forceinline__ void p10_router(const In& I, unsigned char* ws, float* WE, LAS unsigned* lcnt, int bx, int gw, int NGW, int tid, int lane) {
    { f32x4 wv[16];
#pragma unroll
      for (int i = 0; i < 16; ++i) wv[i] = ((const GAS f32x4*)I.w_expert)[tid + 512 * i];
#pragma unroll
      for (int i = 0; i < 16; ++i) { const int e = 4 * (tid + 512 * i), k = e >> 5, c = e & 31; WE[c * WE_P + k] = wv[i][0]; WE[(c + 1) * WE_P + k] = wv[i][1]; WE[(c + 2) * WE_P + k] = wv[i][2]; WE[(c + 3) * WE_P + k] = wv[i][3]; } }
    if (tid < 32) lcnt[tid] = 0u;
    __syncthreads();
    const GAS bf16* DL = (const GAS bf16*)(ws + WS_DL); GAS bf16* VN = (GAS bf16*)(ws + WS_XN); GAS float* TOKW = (GAS float*)(ws + WS_TOKW); GAS int* TOKE = (GAS int*)(ws + WS_TOKE); GAS int* HIST = (GAS int*)(ws + WS_HIST);
    f32x4 nf[4]; f32x4 wgv[16];
#pragma unroll
    for (int q = 0; q < 4; ++q) { nf[q] = *(const GAS f32x4*)(I.norm_ffn + 4 * lane + 256 * q);
#pragma unroll
        for (int i = 0; i < 4; ++i) wgv[4 * q + i] = *(const GAS f32x4*)(I.w_group + 4 * (4 * lane + 256 * q + i)); }
    f32x4 hn[4];
#define RT_LOAD(t_) do { const int rr_ = ((t_) >> 12) * LP + PADF + NMETA + ((t_) & 4095); const GAS float* xp = (const GAS float*)(I.x + (size_t)(t_) * 1024 + 4 * lane); const GAS bf16* dp = DL + (size_t)rr_ * 1024 + 4 * lane; \
        _Pragma("unroll") for (int q = 0; q < 4; ++q) { const u32x2 dw = *(const GAS u32x2*)(dp + 256 * q); hn[q] = *(const GAS f32x4*)(xp + 256 * q) + (f32x4){bflo(dw.x), bfhi(dw.x), bflo(dw.y), bfhi(dw.y)}; } } while (0)
    if (gw < NB * SEQ) RT_LOAD(gw);
    for (int t = gw; t < NB * SEQ; t += NGW) { const int row = (t >> 12) * LP + PADF + NMETA + (t & 4095);
        f32x4 v[4]; float s = 0.f;
#pragma unroll
        for (int q = 0; q < 4; ++q) { v[q] = hn[q]; s += (v[q][0] * v[q][0] + v[q][1] * v[q][1]) + (v[q][2] * v[q][2] + v[q][3] * v[q][3]); }
        { const int tn = t + NGW; if (tn < NB * SEQ) RT_LOAD(tn); }
        const float rs = rsqrtf(wave_sum(s) * (1.f / DM) + EPS);
        float gl[4] = {0.f, 0.f, 0.f, 0.f};
#pragma unroll
        for (int q = 0; q < 4; ++q) { v[q] = v[q] * rs * nf[q];
            *(GAS u32x2*)(VN + (size_t)row * 1024 + 4 * lane + 256 * q) = (u32x2){cvtpk(v[q][0], v[q][1]), cvtpk(v[q][2], v[q][3])};
#pragma unroll
            for (int i = 0; i < 4; ++i) { const f32x4 wg = wgv[4 * q + i]; gl[0] += v[q][i] * wg[0]; gl[1] += v[q][i] * wg[1]; gl[2] += v[q][i] * wg[2]; gl[3] += v[q][i] * wg[3]; } }
        {
          const int hi = lane >> 5, b4 = (lane >> 4) & 1;
          const float s0 = hi ? gl[0] : gl[2], s1 = hi ? gl[1] : gl[3];
          const float k0 = (hi ? gl[2] : gl[0]) + __shfl_xor(s0, 32), k1 = (hi ? gl[3] : gl[1]) + __shfl_xor(s1, 32);
          float k = (b4 ? k1 : k0) + __shfl_xor(b4 ? k0 : k1, 16);
          k += __shfl_xor(k, 8); k += __shfl_xor(k, 4); k += __shfl_xor(k, 2); k += __shfl_xor(k, 1);
#pragma unroll
          for (int i = 0; i < 4; ++i) gl[i] = __int_as_float(__builtin_amdgcn_readlane(__float_as_int(k), 32 * (i >> 1) + 16 * (i & 1))) + I.b_group[i]; }
        int g = 0; float gm = gl[0];
#pragma unroll
        for (int i = 1; i < 4; ++i) if (gl[i] > gm) { gm = gl[i]; g = i; }
        float den = 0.f;
#pragma unroll
        for (int i = 0; i < 4; ++i) den += __expf(gl[i] - gm);
        const float pg = 1.f / den;
        float el[8];
#pragma unroll
        for (int i = 0; i < 8; ++i) { const float* wp = WE + (8 * g + i) * WE_P + 4 * lane; float a = 0.f;
#pragma unroll
            for (int q = 0; q < 4; ++q) { const f32x4 w4 = *(const f32x4*)(wp + 256 * q); a += (v[q][0] * w4[0] + v[q][1] * w4[1]) + (v[q][2] * w4[2] + v[q][3] * w4[3]); }
            el[i] = a; }
        {
          const int hi = lane >> 5, b4 = (lane >> 4) & 1, b3 = (lane >> 3) & 1; float k4[4], k2[2];
#pragma unroll
          for (int i = 0; i < 4; ++i) k4[i] = (hi ? el[4 + i] : el[i]) + __shfl_xor(hi ? el[i] : el[4 + i], 32);
#pragma unroll
          for (int i = 0; i < 2; ++i) k2[i] = (b4 ? k4[2 + i] : k4[i]) + __shfl_xor(b4 ? k4[i] : k4[2 + i], 16);
          float k = (b3 ? k2[1] : k2[0]) + __shfl_xor(b3 ? k2[0] : k2[1], 8);
          k += __shfl_xor(k, 4); k += __shfl_xor(k, 2); k += __shfl_xor(k, 1);
#pragma unroll
          for (int i = 0; i < 8; ++i) el[i] = __int_as_float(__builtin_amdgcn_readlane(__float_as_int(k), 32 * (i >> 2) + 16 * ((i >> 1) & 1) + 8 * (i & 1))) + I.b_expert[8 * g + i]; }
        int i0 = 0; float v0 = el[0];
#pragma unroll
        for (int i = 1; i < 8; ++i) if (el[i] > v0) { v0 = el[i]; i0 = i; }
        int i1 = -1; float v1 = -3.0e38f;
#pragma unroll
        for (int i = 0; i < 8; ++i) if (i != i0 && el[i] > v1) { v1 = el[i]; i1 = i; }
        if (i1 < 0) i1 = i0 == 0 ? 1 : 0;
        const float w0 = 1.f / (1.f + __expf(v1 - v0)), w1 = 1.f - w0;
        if (lane == 0) { const int e0 = 8 * g + i0, e1 = 8 * g + i1;
            const unsigned r0 = __hip_atomic_fetch_add(lcnt + e0, 1u, __ATOMIC_RELAXED, __HIP_MEMORY_SCOPE_WORKGROUP), r1 = __hip_atomic_fetch_add(lcnt + e1, 1u, __ATOMIC_RELAXED, __HIP_MEMORY_SCOPE_WORKGROUP);
            TOKE[row * 2] = e0 | (int)(r0 << 8); TOKE[row * 2 + 1] = e1 | (int)(r1 << 8);
            TOKW[row * 2] = w0 * pg; TOKW[row * 2 + 1] = w1 * pg; }
    }
#undef RT_LOAD
    __syncthreads();
    if (tid < 32) HIST[bx * 32 + tid] = (int)lcnt[tid];
}
__device__ __forceinline__ void moe_bases(unsigned char* ws, volatile LAS int* ost, volatile LAS int* cnt, volatile LAS int* base, volatile LAS int* part, int bx, int G, int tid) {
    const int* HIST = (const int*)(ws + WS_HIST); int* CNTG = (int*)(ws + WS_CNTG);
    __syncthreads();
    { const int e = tid & 31, pi = tid >> 5, per = (G + 15) >> 4, w0 = pi * per; int tot = 0, bs = 0;
#pragma unroll 16
      for (int i = 0; i < per; ++i) { const int w = w0 + i; if (w < G) { const int hc = HIST[w * 32 + e]; tot += hc; bs += (w < bx) ? hc : 0; } }
      part[pi * 32 + e] = tot; part[512 + pi * 32 + e] = bs; }
    __syncthreads();
    if (tid < 32) { int tot = 0, bs = 0;
#pragma unroll
        for (int pi = 0; pi < 16; ++pi) { tot += part[pi * 32 + tid]; bs += part[512 + pi * 32 + tid]; }
        cnt[tid] = tot; base[tid] = bs; if (bx == 0) CNTG[tid] = tot; }
    __syncthreads();
    if (tid == 0) { int a = 0; for (int e = 0; e < NEXP; ++e) { ost[e] = a; a += (cnt[e] + 255) & ~255; } ost[NEXP] = a; }
    __syncthreads();
}
__device__ __forceinline__ void moe_offsets(unsigned char* ws, volatile LAS int* ost, volatile LAS int* cnt, int tid) {
    const int* CNTG = (const int*)(ws + WS_CNTG);
    __syncthreads();
    if (tid < 32) cnt[tid] = CNTG[tid];
    __syncthreads();
    if (tid == 0) { int a = 0; for (int e = 0; e < NEXP; ++e) { ost[e] = a; a += (cnt[e] + 255) & ~255; } ost[NEXP] = a; }
    __syncthreads();
}
__device__ __forceinline__ void p11_index(unsigned char* ws, volatile LAS int* ost, volatile LAS int* cnt, volatile LAS int* base, int gw, int NGW, int lane) {
    const int* TOKE = (const int*)(ws + WS_TOKE); int* PROW = (int*)(ws + WS_PROW); int* GIDX = (int*)(ws + WS_GIDX);
    for (int t = gw; t < NB * SEQ; t += NGW) { const int row = (t >> 12) * LP + PADF + NMETA + (t & 4095);
        if (lane < 2) { const int code = TOKE[row * 2 + lane]; const int e = code & 255, pr = ost[e] + base[e] + (code >> 8); GIDX[pr] = row; PROW[pr] = row * 2 + lane; } }
    for (int e = 0; e < NEXP; ++e) { const int p0 = ost[e] + cnt[e], np = ost[e + 1] - p0;
        for (int j = gw * 64 + lane; j < np; j += NGW * 64) { GIDX[p0 + j] = 0; PROW[p0 + j] = -1; } }
}
__device__ __forceinline__ void p13_final(const In& I, unsigned char* ws, float* out, int gw, int NGW, int lane, bool poison) {
    const bf16* DL = (const bf16*)(ws + WS_DL); const bf16* YP = (const bf16*)(ws + WS_YP);
    f32x4 nfv[4];
#pragma unroll
    for (int j = 0; j < 4; ++j) nfv[j] = *(const f32x4*)(I.norm_final + 4 * (lane + 64 * j));
    for (int t = gw; t < NB * SEQ; t += 2 * NGW) {
        const int t2 = t + NGW; const bool has2 = t2 < NB * SEQ; const int tb = has2 ? t2 : t;
        const size_t row = (size_t)(t >> 12) * LP + PADF + NMETA + (t & 4095), row2 = (size_t)(tb >> 12) * LP + PADF + NMETA + (tb & 4095);
        f32x4 h[4], h2[4]; u32x2 ya[4], yb[4], ya2[4], yb2[4], da[4], da2[4];
#pragma unroll
        for (int j = 0; j < 4; ++j) { const int c = 4 * (lane + 64 * j); h[j] = *(const f32x4*)(I.x + (size_t)t * 1024 + c); da[j] = *(const u32x2*)(DL + row * 1024 + c); ya[j] = *(const u32x2*)(YP + row * 1024 + c); yb[j] = *(const u32x2*)(YP + ((size_t)MROWS + row) * 1024 + c);
            h2[j] = *(const f32x4*)(I.x + (size_t)tb * 1024 + c); da2[j] = *(const u32x2*)(DL + row2 * 1024 + c); ya2[j] = *(const u32x2*)(YP + row2 * 1024 + c); yb2[j] = *(const u32x2*)(YP + ((size_t)MROWS + row2) * 1024 + c); }
#define FIN_ROW(H, YA, YB, DA, T) do { float s = 0.f; \
        _Pragma("unroll") for (int j = 0; j < 4; ++j) { H[j] += (f32x4){bflo(DA[j].x), bfhi(DA[j].x), bflo(DA[j].y), bfhi(DA[j].y)}; H[j] += (f32x4){bflo(YA[j].x) + bflo(YB[j].x), bfhi(YA[j].x) + bfhi(YB[j].x), bflo(YA[j].y) + bflo(YB[j].y), bfhi(YA[j].y) + bfhi(YB[j].y)}; \
            s += (H[j][0] * H[j][0] + H[j][1] * H[j][1]) + (H[j][2] * H[j][2] + H[j][3] * H[j][3]); } \
        const float rs = rsqrtf(wave_sum(s) * (1.f / DM) + EPS); \
        _Pragma("unroll") for (int j = 0; j < 4; ++j) { f32x4 o = H[j] * rs * nfv[j]; if (poison) { const float q = __builtin_nanf(""); o = (f32x4){q, q, q, q}; } *(f32x4*)(out + (size_t)(T) * DM + 4 * (lane + 64 * j)) = o; } } while (0)
        FIN_ROW(h, ya, yb, da, t);
        if (has2) FIN_ROW(h2, ya2, yb2, da2, t2);
#undef FIN_ROW
    }
}

constexpr int NPHASE = 15;
struct Args { const float* in[26]; float* out; unsigned char* ws; };
template <int LO, int HI> __global__ void __launch_bounds__(512, 2) mk_fwd(Args args) {
    extern __shared__ __attribute__((aligned(16))) unsigned char lds[];
    LAS unsigned char* L3 = (LAS unsigned char*)lds;
    volatile LAS unsigned* MISC = (volatile LAS unsigned*)(L3 + MISC_OFF);
    const int G = gridDim.x; const int bx = blockIdx.x; const int vcu = (G % 8 == 0) ? (bx % 8) * (G / 8) + bx / 8 : bx;
    const int NGW = G * 8;
    unsigned char* ws = args.ws; unsigned* ctl = (unsigned*)(ws + WS_CTL);
    { const int t0 = threadIdx.x;
      for (int u = t0; u < (LDS_BYTES - MISC_OFF) / 4; u += 512) MISC[u] = 0u;
      __syncthreads();
      if (t0 == 0) {
#pragma unroll
          for (int k = 0; k < 26; ++k) { const unsigned long long p = (unsigned long long)args.in[k]; MISC[64 + 2 * k] = (unsigned)p; MISC[65 + 2 * k] = (unsigned)(p >> 32); } }
      __syncthreads(); }
#define PH_IDS int tid = threadIdx.x; asm volatile("" : "+v"(tid) :: "memory"); const int lane = tid & 63, wave = __builtin_amdgcn_readfirstlane(tid >> 6), gw = vcu * 8 + wave; (void)lane; (void)gw;
#define INP(k) ((const float*)(((unsigned long long)(unsigned)__builtin_amdgcn_readfirstlane(MISCNV[65 + 2 * (k)]) << 32) | (unsigned long long)(unsigned)__builtin_amdgcn_readfirstlane(MISCNV[64 + 2 * (k)])))
#define PH_IN In I; I.x = INP(0); I.meta = INP(1); I.norm_mix = INP(2); I.w_in = INP(3); I.q_norm = INP(4); I.w_uq = INP(5); I.kv_norm = INP(6); I.w_ukv = INP(7); \
    I.conv_w = INP(8); I.conv_b = INP(9); I.dt_bias = INP(10); I.a_log = INP(11); I.d_skip = INP(12); I.ssm_norm = INP(13); I.w_ba = INP(14); I.w_bs = INP(15); \
    I.w_out = INP(16); I.norm_ffn = INP(17); I.w_group = INP(18); I.b_group = INP(19); I.w_expert = INP(20); I.b_expert = INP(21); I.w_gate = INP(22); I.w_up = INP(23); \
    I.w_down = INP(24); I.norm_final = INP(25);
    const LAS unsigned* MISCNV = (const LAS unsigned*)(L3 + MISC_OFF);
    XcdBarrier bar; bar.bar = ctl + CW_BAR + LO * XCD_BAR_WORDS; bar.x = 0; bar.st = nullptr;
    if (HI - LO > 1) bar = xcd_barrier_post(ctl + CW_BAR + LO * XCD_BAR_WORDS, MISC + 8);
#ifndef PH_MASK
#define PH_MASK 0x7fff
#endif
#define IN(k) (((PH_MASK >> (k)) & 1) && LO <= (k) && (k) < HI)
#ifdef PRB_SLACK
#define SEAM(k) do { if (LO <= (k) && (k) + 1 < HI) { const unsigned long long t0_ = wall_clock64(); xcd_barrier(bar); if (((PRB_SLACK >> (k)) & 1) && threadIdx.x == 0) MISC[10] += (unsigned)(wall_clock64() - t0_); } } while (0)
#else
#define SEAM(k) do { if (LO <= (k) && (k) + 1 < HI) xcd_barrier(bar); } while (0)
#endif

#define PH_PTRS unsigned char* wsp = ws; float* outp = args.out; asm volatile("" : "+s"(wsp), "+s"(outp)); \
bf16 *WinA = (bf16*)(wsp + WS_WINA), *WinB = (bf16*)(wsp + WS_WINB), *Wuq = (bf16*)(wsp + WS_WUQ), *Wukv = (bf16*)(wsp + WS_WUKV), *Wba = (bf16*)(wsp + WS_WBA), *Wbs = (bf16*)(wsp + WS_WBS), \
         *Wout = (bf16*)(wsp + WS_WOUT), *Wgu = (bf16*)(wsp + WS_WGU), *Wd = (bf16*)(wsp + WS_WD); \
    float* CS = (float*)(wsp + WS_CS); \
    bf16 *XN = (bf16*)(wsp + WS_XN), *KV = (bf16*)(wsp + WS_KV), *SA = (bf16*)(wsp + WS_SA), *SS = (bf16*)(wsp + WS_SS), *XBC = (bf16*)(wsp + WS_XBC), *MRG = (bf16*)(wsp + WS_MRG), *Y = (bf16*)(wsp + WS_Y), \
         *CQ = (bf16*)(wsp + WS_CQ), *CKV = (bf16*)(wsp + WS_CKV), *KR = (bf16*)(wsp + WS_KR), *VP = (bf16*)(wsp + WS_VP), *YP = (bf16*)(wsp + WS_YP), *HM = (bf16*)(wsp + WS_HM); \
    float *H1 = (float*)(wsp + WS_H1), *DT = (float*)(wsp + WS_DT), *SSQ = (float*)(wsp + WS_SSQ), *SSKV = (float*)(wsp + WS_SSKV), *TOKW = (float*)(wsp + WS_TOKW); \
    int* PROW = (int*)(wsp + WS_PROW); float* KRF = (float*)(wsp + WS_KRF); bf16 *ZB = (bf16*)(wsp + WS_Z), *DLB = (bf16*)(wsp + WS_DL); \
    bf16 *Qn = (bf16*)outp, *Qr = (bf16*)outp + (size_t)MROWS * 1024;
    if constexpr (IN(0)) { PH_PTRS PH_IDS PH_IN p0_prologue(I, ws, L3, gw, NGW, wave, lane); }
    SEAM(0);
    if constexpr (IN(1)) { PH_PTRS
        pg8::Gemm g{XN, WinA, MROWS, 1792, 1024}; StdOrder S; S.init(MROWS, 1792, G, bx);
        EpiInA E{CQ, CKV, XBC, KRF, DT, SSQ, SSKV};
        pg8::gemm_phase<EpiInA, StdOrder, true, true>(L3, g, S, E);
    }
    SEAM(1);
    if constexpr (IN(2)) { PH_PTRS
        PH_IDS PH_IN
        p2_rowpass(KRF, KR, DT, CS, I.dt_bias, gw * 64 + lane, NGW * 64);
        pg8::Gemm g{CQ, Wuq, MROWS, 1536, 256}; TokOrder S; S.init(1536, G, bx); EpiQ E{Qn, Qr, SSQ, CS};
        pg8::gemm_phase<EpiQ, TokOrder, true, true>(L3, g, S, E);
    }
    if constexpr (LO <= 2 && 3 < HI) __syncthreads();
    if constexpr (IN(3)) { PH_PTRS
        pg8::Gemm g{CKV, Wukv, MROWS, 2048, 128}; StdOrder S; S.init(MROWS, 2048, G, bx); EpiKV E{KV, SSKV};
        pg8::gemm_phase<EpiKV, StdOrder, true, true>(L3, g, S, E);
    }
    SEAM(3);
    if constexpr (IN(4)) { PH_PTRS
        PH_IDS PH_IN
        constexpr int NSSD = NB * NHEAD / 2;
#ifndef NO_SSD
        for (;;) {
            __syncthreads();
            if (tid == 0) MISC[0] = atomicAdd(ctl + CW_Q3, 1u);
            __syncthreads();
            const int u = (int)MISC[0];
            if (u >= NSSD) break;
#ifdef PRB_SSDT
            const unsigned long long ts0_ = wall_clock64();
#endif
            ssd_unit(u >> 3, u & 7, I, XBC, DT, Y, L3, tid);
#ifdef PRB_SSDT
            if (threadIdx.x == 0) MISC[10] += (unsigned)(wall_clock64() - ts0_);
#endif
        }
#endif
#ifndef NO_ATT
        for (;;) {
            __syncthreads();
            if (tid == 0) MISC[1] = atomicAdd(ctl + CW_Q3 + 1, 1u);
            __syncthreads();
            const int a = (int)MISC[1];
            if (a >= 17 * 64) break;
            const int jb = 16 - a / 64, rem = a % 64; attn_unit(rem >> 3, rem & 7, jb, Qn, Qr, KV, KR, Qn, 0xffffffffu, L3, tid);
        }
#endif
    }
    SEAM(4);
    if constexpr (IN(5)) { PH_PTRS
        pg8::Gemm g{XN, WinB, MROWS, 3072, 1024}; TokOrder S; S.init(3072, G, bx); EpiZG E{ZB, SA, SS};
        pg8::gemm_phase<EpiZG, TokOrder, true, true>(L3, g, S, E);
    }
    SEAM(5);
    if constexpr (IN(6)) { PH_PTRS PH_IDS p5_groupnorm(Y, ZB, gw, NGW, lane); }
    SEAM(6);
    if constexpr (IN(7)) { PH_PTRS
        pg8::Gemm g{Qn, Wba, MROWS, 1024, 1024}; TokOrder S; S.init(1024, G, bx); EpiBr<0> E{MRG, SA};
        pg8::gemm_phase<EpiBr<0>, TokOrder, true, true>(L3, g, S, E);
    }
    if constexpr (LO <= 7 && 8 < HI) __syncthreads();
    if constexpr (IN(8)) { PH_PTRS
        pg8::Gemm g{Y, Wbs, MROWS, 1024, 1024}; TokOrder S; S.init(1024, G, bx); EpiBr<1> E{MRG, SS};
        pg8::gemm_phase<EpiBr<1>, TokOrder, true, true>(L3, g, S, E);
    }
    SEAM(8);
    if constexpr (IN(9)) { PH_PTRS
        pg8::Gemm g{MRG, Wout, MROWS, 1024, 1024}; TokOrder S; S.init(1024, G, bx); EpiOut E{DLB};
        pg8::gemm_phase<EpiOut, TokOrder, true, true>(L3, g, S, E);
    }
    SEAM(9);
    volatile LAS int* ost = (volatile LAS int*)(MISC + 16);
    if constexpr (IN(10)) { PH_PTRS PH_IDS PH_IN p10_router(I, ws, (float*)lds, (LAS unsigned*)(L3 + MISC_OFF) + 128, bx, gw, NGW, tid, lane); }
    SEAM(10);
    if constexpr (IN(11)) { PH_PTRS PH_IDS moe_bases(ws, ost, (volatile LAS int*)(MISC + 128), (volatile LAS int*)(MISC + 160), (volatile LAS int*)L3, bx, G, tid); p11_index(ws, ost, (volatile LAS int*)(MISC + 128), (volatile LAS int*)(MISC + 160), gw, NGW, lane); }
    SEAM(11);
    if constexpr (IN(12)) { PH_PTRS
        PH_IDS moe_offsets(ws, ost, (volatile LAS int*)(MISC + 128), tid);
        pg8::Gemm g{XN, Wgu, VPROWS, 16384, 1024}; MoeOrder S{(const LAS int*)ost, 2, G, bx}; EpiGU E{HM};
        pg8::gemm_phase<EpiGU, MoeOrder, true, true, true>(L3, g, S, E, (const int*)(wsp + WS_GIDX));
    }
    SEAM(12);
    if constexpr (IN(13)) { PH_PTRS
        PH_IDS moe_offsets(ws, ost, (volatile LAS int*)(MISC + 128), tid);
        pg8::Gemm g{HM, Wd, VPROWS, 32768, 256}; MoeOrder S{(const LAS int*)ost, 4, G, bx}; EpiDown E{YP, PROW, TOKW};
        pg8::gemm_phase<EpiDown, MoeOrder, true, true>(L3, g, S, E);
    }
    SEAM(13);
#ifdef PRB_SLACK
    { if (threadIdx.x == 0) atomicAdd(ctl + 3000, MISC[10]); xcd_barrier(bar);
      const unsigned tot = xb_ld(ctl + 3000); const unsigned long long wait_ = (unsigned long long)tot * PRB_K / (unsigned)G; const unsigned long long ts_ = wall_clock64();
      while (wall_clock64() - ts_ < wait_) __builtin_amdgcn_s_sleep(8);
      __syncthreads(); }
#endif
    if constexpr (IN(14)) { PH_PTRS PH_IDS PH_IN const bool poison = __hip_atomic_load(bar.bar + XB_TMO, __ATOMIC_RELAXED, __HIP_MEMORY_SCOPE_AGENT) != 0u; p13_final(I, ws, args.out, gw, NGW, lane, poison); }
#undef IN
#undef SEAM
}

#ifndef MK_ONE_LAUNCH
#define MK_ONE_LAUNCH 1
#endif
template <int P> static void launch_phases(int grid, hipStream_t stream, const Args& a) {
    if constexpr (P < NPHASE) { hipLaunchKernelGGL((mk_fwd<P, P + 1>), dim3(grid), dim3(512), LDS_BYTES, stream, a); launch_phases<P + 1>(grid, stream, a); }
}
template <int P> static bool set_attr_phases() {
    if constexpr (P < NPHASE) { if (hipFuncSetAttribute((const void*)mk_fwd<P, P + 1>, hipFuncAttributeMaxDynamicSharedMemorySize, LDS_BYTES) != hipSuccess) return false; return set_attr_phases<P + 1>(); }
    else return true;
}
extern "C" void kernel_launch(void* const* d_in, const int* in_sizes, int n_in, void* d_out, int out_size, void* d_ws, size_t ws_size, hipStream_t stream) {
    static int grid = 0;
    if (grid == 0) {
        if (n_in != 26 || out_size != NB * SEQ * DM || ws_size < WS_END) { fprintf(stderr, "kernel_launch: unexpected problem (n_in %d, out %d, ws %zu); nothing launched\n", n_in, out_size, ws_size); grid = -1; return; }
        int dev = 0, cus = 0;
        if (hipGetDevice(&dev) != hipSuccess || hipDeviceGetAttribute(&cus, hipDeviceAttributeMultiprocessorCount, dev) != hipSuccess) { grid = -1; return; }
#if MK_ONE_LAUNCH
        if (hipFuncSetAttribute((const void*)mk_fwd<0, NPHASE>, hipFuncAttributeMaxDynamicSharedMemorySize, LDS_BYTES) != hipSuccess) { fprintf(stderr, "kernel_launch: hipFuncSetAttribute failed\n"); grid = -1; return; }
#else
        if (!set_attr_phases<0>()) { fprintf(stderr, "kernel_launch: hipFuncSetAttribute failed\n"); grid = -1; return; }
#endif
        (void)hipGetLastError();
        grid = cus;
    }
    if (grid < 0) return;
    (void)hipMemsetAsync((char*)d_ws + WS_CTL, 0, CTL_ZERO_BYTES, stream);
    Args a{};
    for (int i = 0; i < 26; ++i) a.in[i] = (const float*)d_in[i];
    a.out = (float*)d_out; a.ws = (unsigned char*)d_ws;
#if MK_ONE_LAUNCH
    hipLaunchKernelGGL((mk_fwd<0, NPHASE>), dim3(grid), dim3(512), LDS_BYTES, stream, a);
#else
    launch_phases<0>(grid, stream, a);
#endif
}
```

```cpp
#include <hip/hip_runtime.h>
#include <cstdio>
#include <cstdint>
namespace pg8 {
#define PG8_LAS __attribute__((address_space(3)))
typedef unsigned short bf16_t;
typedef short bf16x8 __attribute__((ext_vector_type(8)));
typedef float f32x4 __attribute__((ext_vector_type(4)));
typedef unsigned u32x4 __attribute__((ext_vector_type(4)));
constexpr int BM = 256, BK = 64, HALF = 128, HTB = HALF * BK * 2  , STAGE_BYTES = 8 * HTB, NXCD = 8, WGM = 8;

__host__ __device__ __forceinline__ int lds_byte(int r, int c) { const int st = (r >> 4) * 2 + (c >> 5), rr = r & 15, cc = c & 31, ob = rr * 64 + cc * 2; return st * 1024 + (ob ^ (((ob >> 9) & 1) << 5)); }
__host__ __device__ __forceinline__ void stage_rc(int b, int& R, int& C) { const int st = b / 1024, sb = b % 1024, swz = sb ^ (((sb >> 9) & 1) << 5); R = (st >> 1) * 16 + swz / 64; C = (st & 1) * 32 + (swz % 64) / 2; }
__host__ __device__ __forceinline__ int perm32(int rho) { const int n = rho >> 4, i = rho & 15; return 8 * (i >> 2) + 4 * n + (i & 3); }

struct Unit { int pm, pn; };
struct Gemm { const bf16_t* A; const bf16_t* Bt; int M, N, K; };

struct StaticOrder {
    int nM, nN, nwg, G, c;
    __host__ __device__ void init(int M, int N, int G_, int c_) { nM = M / BM; nN = N / BM; nwg = nM * nN; G = G_; c = c_; }
    __host__ __device__ bool next(int i, Unit& u) const {
        const long L = (long)i * G + c; if (L >= nwg) return false;
        int wgid = (int)L; { const int q = nwg / NXCD, r = nwg % NXCD, xcd = wgid % NXCD, off = wgid / NXCD; wgid = (xcd < r ? xcd * (q + 1) : r * (q + 1) + (xcd - r) * q) + off; }
        const int nig = WGM * nN, gid = wgid / nig, fm = gid * WGM, gsz = (nM - fm) < WGM ? (nM - fm) : WGM;
        u.pm = fm + ((wgid % nig) % gsz); u.pn = (wgid % nig) / gsz; return true;
    }
    __device__ __forceinline__ void a_ready(const Unit&) const {}
    __device__ __forceinline__ void done(const Unit&) const {}
};

__device__ __forceinline__ unsigned cvt_pk_bf16(float lo, float hi) { unsigned r; asm volatile("v_cvt_pk_bf16_f32 %0, %1, %2" : "=v"(r) : "v"(lo), "v"(hi)); return r; }
template <class Epi, class Sched, bool ALIGN_EPI = false, bool SP2 = false, bool GATHER = false>
__device__ __forceinline__ void gemm_phase(PG8_LAS unsigned char* lds, const Gemm g, const Sched& S, const Epi& E, const int* gidx = nullptr) {
    int tid_ = threadIdx.x; asm volatile("" : "+v"(tid_));
    const int tid = tid_, wid = __builtin_amdgcn_readfirstlane(tid >> 6), lane = tid & 63, wr = wid >> 2, wc = wid & 3, fr = lane & 15, fq = lane >> 4;
    const int K = g.K, nt = K / BK;
    unsigned voffA[2], voffB[2]; int gR[2]; unsigned gC[2];
#pragma unroll
    for (int i = 0; i < 2; ++i) { int R, C; stage_rc(tid * 16 + i * 8192, R, C); const int Rb = Epi::PERM ? ((R & ~31) + perm32(R & 31)) : R;
        voffA[i] = (unsigned)(R * K + C) * 2u; voffB[i] = (unsigned)(Rb * K + C) * 2u; gR[i] = R; gC[i] = (unsigned)C * 2u; }
    unsigned gA0[2] = {0u, 0u}, gA1[2] = {0u, 0u}, nA0[2] = {0u, 0u}, nA1[2] = {0u, 0u};
#define PG8_GOFF(o0, o1, pm_) do { _Pragma("unroll") for (int _i = 0; _i < 2; ++_i) { o0[_i] = (unsigned)gidx[(pm_) * 128 + gR[_i]] * (unsigned)(K * 2) + gC[_i]; o1[_i] = (unsigned)gidx[(pm_) * 128 + 128 + gR[_i]] * (unsigned)(K * 2) + gC[_i]; } } while (0)
#define PG8_STAGE_A(bufoff, kb, h, nx) do { if constexpr (GATHER) { unsigned _o[2]; _o[0] = (nx) ? ((h) ? nA1[0] : nA0[0]) : ((h) ? gA1[0] : gA0[0]); _o[1] = (nx) ? ((h) ? nA1[1] : nA0[1]) : ((h) ? gA1[1] : gA0[1]); PG8_STAGE(bufoff, (const char*)g.A + (kb), _o); } \
        else { PG8_STAGE(bufoff, ((nx) ? nA : cA) + (kb) + (size_t)(h) * hstep, voffA); } } while (0)
    const size_t kstep = (size_t)(BK * 2);
    const size_t hstep = (size_t)HALF * K * 2;
    const size_t tstep = 2 * hstep;
    const unsigned ldsw = (unsigned)wid * 1024u;
    const int aoff = lds_byte(wr * 64 + fr, fq * 8), boff = lds_byte(wc * 32 + fr, fq * 8);
#define PG8_SA(b, h) (((b) * 2 + (h)) * HTB)
#define PG8_SB(b, h) ((4 + (b) * 2 + (h)) * HTB)
#define PG8_STAGE(bufoff, gbase, voff) do { _Pragma("unroll") for (int _i = 0; _i < 2; ++_i) \
        __builtin_amdgcn_global_load_lds((const unsigned*)((const char*)(gbase) + (voff)[_i]), (PG8_LAS unsigned*)(lds + (bufoff) + ldsw + _i * 8192), 16, 0, 0); } while (0)
#define PG8_LDA(dst, b, h) do { _Pragma("unroll") for (int m = 0; m < 4; ++m) _Pragma("unroll") for (int k = 0; k < 2; ++k) dst[m][k] = *(const PG8_LAS bf16x8*)(lds + PG8_SA(b, h) + aoff + m * 2048 + k * 1024); } while (0)
#define PG8_LDB(dst, b, h) do { _Pragma("unroll") for (int n = 0; n < 2; ++n) _Pragma("unroll") for (int k = 0; k < 2; ++k) dst[n][k] = *(const PG8_LAS bf16x8*)(lds + PG8_SB(b, h) + boff + n * 2048 + k * 1024); } while (0)
#define PG8_MMA(ai, bj, At, Bt) do { __builtin_amdgcn_s_setprio(1); _Pragma("unroll") for (int m = 0; m < 4; ++m) _Pragma("unroll") for (int n = 0; n < 2; ++n) _Pragma("unroll") for (int k = 0; k < 2; ++k) \
        acc[ai][bj][m][n] = __builtin_amdgcn_mfma_f32_16x16x32_bf16(Bt[n][k], At[m][k], acc[ai][bj][m][n], 0, 0, 0); __builtin_amdgcn_s_setprio(0); } while (0)
#define PG8_WAIT_V(n) asm volatile("s_waitcnt vmcnt(" #n ")" ::: "memory")
#define PG8_WAIT_L(n) asm volatile("s_waitcnt lgkmcnt(" #n ")" ::: "memory")
#define PG8_BAR __builtin_amdgcn_s_barrier()
#define PG8_SCHED __builtin_amdgcn_sched_barrier(0)
    Unit cur, nxt; int ui = 0;
    if (!S.next(0, cur)) return;
    f32x4 acc[2][2][4][2];
#pragma unroll
    for (int a = 0; a < 2; ++a)
#pragma unroll
        for (int b = 0; b < 2; ++b)
#pragma unroll
            for (int m = 0; m < 4; ++m)
#pragma unroll
                for (int n = 0; n < 2; ++n) acc[a][b][m][n] = (f32x4){0.f, 0.f, 0.f, 0.f};
    bf16x8 At[4][2], B0[2][2], B1[2][2];
    const char* cA = (const char*)g.A + (size_t)cur.pm * hstep; const char* cB = (const char*)g.Bt + (size_t)cur.pn * tstep;
    if constexpr (GATHER) PG8_GOFF(gA0, gA1, cur.pm);
    const char* nA = cA;
    S.a_ready(cur);
    if constexpr (SP2) {
        PG8_STAGE(PG8_SB(0, 0), cB, voffB); PG8_STAGE(PG8_SB(0, 1), cB + hstep, voffB); PG8_STAGE_A(PG8_SA(0, 0), 0, 0, false); PG8_STAGE_A(PG8_SA(0, 1), 0, 1, false);
        if (wr == 1) PG8_BAR;
        PG8_WAIT_V(2); PG8_BAR;
        PG8_STAGE(PG8_SB(1, 0), cB + kstep, voffB); PG8_STAGE_A(PG8_SA(1, 0), kstep, 0, false); PG8_STAGE(PG8_SB(1, 1), cB + hstep + kstep, voffB);
        PG8_WAIT_V(6); PG8_BAR;
    } else {
        PG8_STAGE(PG8_SB(0, 0), cB, voffB); PG8_STAGE_A(PG8_SA(0, 0), 0, 0, false); PG8_STAGE(PG8_SB(0, 1), cB + hstep, voffB); PG8_STAGE_A(PG8_SA(0, 1), 0, 1, false);
        if (wr == 1) PG8_BAR;
        PG8_WAIT_V(4); PG8_BAR;
        PG8_STAGE(PG8_SB(1, 0), cB + kstep, voffB); PG8_STAGE_A(PG8_SA(1, 0), kstep, 0, false); PG8_STAGE(PG8_SB(1, 1), cB + hstep + kstep, voffB);
        PG8_WAIT_V(6); PG8_BAR;
    }
    for (;;) {
        const bool has_next = S.next(ui + 1, nxt);
        nA = has_next ? (const char*)g.A + (size_t)nxt.pm * hstep : cA; const char* nB = has_next ? (const char*)g.Bt + (size_t)nxt.pn * tstep : cB;
        if constexpr (GATHER) { if (has_next) PG8_GOFF(nA0, nA1, nxt.pm); else { nA0[0] = gA0[0]; nA0[1] = gA0[1]; nA1[0] = gA1[0]; nA1[1] = gA1[1]; } }
        for (int t = 0; t < nt; t += 2) {
            const bool last = (t == nt - 2);
            const size_t k1 = (size_t)(t + 1) * kstep;
            const size_t k2 = last ? 0 : (size_t)(t + 2) * kstep; const char* b2 = last ? nB : cB + (size_t)(t + 2) * kstep;
            const size_t k3 = k2 + kstep; const char* b3 = b2 + kstep;
            if (last && has_next) S.a_ready(nxt);
            if constexpr (SP2) {
            PG8_LDB(B0, 0, 0); PG8_LDB(B1, 0, 1); PG8_SCHED; PG8_LDA(At, 0, 0); PG8_STAGE_A(PG8_SA(1, 1), k1, 1, false);
            PG8_WAIT_V(8); PG8_WAIT_L(0); PG8_BAR; PG8_MMA(0, 0, At, B0); PG8_MMA(0, 1, At, B1); PG8_BAR; PG8_SCHED;
            PG8_LDA(At, 0, 1); PG8_STAGE(PG8_SB(0, 0), b2, voffB); PG8_STAGE(PG8_SB(0, 1), b2 + hstep, voffB); PG8_STAGE_A(PG8_SA(0, 0), k2, 0, last);
            PG8_WAIT_V(8); PG8_WAIT_L(0); PG8_BAR; PG8_MMA(1, 0, At, B0); PG8_MMA(1, 1, At, B1); PG8_BAR; PG8_SCHED;
            PG8_LDB(B0, 1, 0); PG8_LDB(B1, 1, 1); PG8_SCHED; PG8_LDA(At, 1, 0); PG8_STAGE_A(PG8_SA(0, 1), k2, 1, last);
            PG8_WAIT_V(8); PG8_WAIT_L(0); PG8_BAR; PG8_MMA(0, 0, At, B0); PG8_MMA(0, 1, At, B1); PG8_BAR; PG8_SCHED;
            PG8_LDA(At, 1, 1); PG8_STAGE(PG8_SB(1, 0), b3, voffB); PG8_STAGE(PG8_SB(1, 1), b3 + hstep, voffB); PG8_STAGE_A(PG8_SA(1, 0), k3, 0, last);
            PG8_WAIT_V(8); PG8_WAIT_L(0); PG8_BAR; PG8_MMA(1, 0, At, B0); PG8_MMA(1, 1, At, B1); PG8_BAR; PG8_SCHED;
            } else {
            PG8_LDB(B0, 0, 0); PG8_SCHED; PG8_LDA(At, 0, 0); PG8_STAGE_A(PG8_SA(1, 1), k1, 1, false);
            PG8_WAIT_L(8); PG8_BAR; PG8_WAIT_L(0); PG8_MMA(0, 0, At, B0); PG8_BAR; PG8_SCHED;
            PG8_LDB(B1, 0, 1); PG8_STAGE(PG8_SB(0, 0), b2, voffB);
            PG8_BAR; PG8_WAIT_L(0); PG8_MMA(0, 1, At, B1); PG8_BAR;
            PG8_LDA(At, 0, 1); PG8_STAGE_A(PG8_SA(0, 0), k2, 0, last);
            PG8_BAR; PG8_WAIT_L(0); PG8_MMA(1, 0, At, B0); PG8_BAR; PG8_SCHED;
            PG8_STAGE(PG8_SB(0, 1), b2 + hstep, voffB);
            PG8_WAIT_V(6); PG8_BAR; PG8_MMA(1, 1, At, B1); PG8_BAR;
            PG8_LDB(B0, 1, 0); PG8_SCHED; PG8_LDA(At, 1, 0); PG8_STAGE_A(PG8_SA(0, 1), k2, 1, last);
            PG8_WAIT_L(8); PG8_BAR; PG8_WAIT_L(0); PG8_MMA(0, 0, At, B0); PG8_BAR; PG8_SCHED;
            PG8_LDB(B1, 1, 1); PG8_STAGE(PG8_SB(1, 0), b3, voffB);
            PG8_BAR; PG8_WAIT_L(0); PG8_MMA(0, 1, At, B1); PG8_BAR;
            PG8_LDA(At, 1, 1); PG8_STAGE_A(PG8_SA(1, 0), k3, 0, last);
            PG8_BAR; PG8_WAIT_L(0); PG8_MMA(1, 0, At, B0); PG8_BAR; PG8_SCHED;
            PG8_STAGE(PG8_SB(1, 1), b3 + hstep, voffB);
            PG8_WAIT_V(6); PG8_BAR; PG8_MMA(1, 1, At, B1); PG8_BAR;
            }
        }
        if constexpr (ALIGN_EPI) { if (wr == 0) PG8_BAR; }
        if constexpr (!Epi::AFTER_DRAIN) { E(acc, cur, wr, wc, fr, fq); S.done(cur); }
        if (!has_next) break;
#pragma unroll
        for (int a = 0; a < 2; ++a)
#pragma unroll
            for (int b = 0; b < 2; ++b)
#pragma unroll
                for (int m = 0; m < 4; ++m)
#pragma unroll
                    for (int n = 0; n < 2; ++n) acc[a][b][m][n] = (f32x4){0.f, 0.f, 0.f, 0.f};
        cur = nxt; cA = nA; cB = nB; ++ui;
        if constexpr (GATHER) { gA0[0] = nA0[0]; gA0[1] = nA0[1]; gA1[0] = nA1[0]; gA1[1] = nA1[1]; }
        if constexpr (ALIGN_EPI) { if (wr == 1) PG8_BAR; }
    }
    PG8_WAIT_V(0);
    if constexpr (!ALIGN_EPI) { if (wr == 0) PG8_BAR; }
    PG8_BAR;
    if constexpr (Epi::AFTER_DRAIN) { E.fused(acc, cur, wr, wc, fr, fq, lds, wid, lane); S.done(cur); }
#undef PG8_SA
#undef PG8_SB
#undef PG8_STAGE
#undef PG8_STAGE_A
#undef PG8_GOFF
#undef PG8_LDA
#undef PG8_LDB
#undef PG8_MMA
#undef PG8_WAIT_V
#undef PG8_WAIT_L
#undef PG8_BAR
#undef PG8_SCHED
}
}
#define GAS __attribute__((address_space(1)))
#define LAS __attribute__((address_space(3)))
typedef unsigned short bf16;
typedef unsigned v4u __attribute__((ext_vector_type(4)));
typedef float f32x4 __attribute__((ext_vector_type(4)));
typedef short bf16x8 __attribute__((ext_vector_type(8)));
typedef GAS unsigned gu32;
typedef GAS unsigned long long gu64;
#define RLX_AGENT __ATOMIC_RELAXED, __HIP_MEMORY_SCOPE_AGENT
#define LDS_WAIT() asm volatile("s_waitcnt lgkmcnt(0)" ::: "memory")
#define VM_WAIT() asm volatile("s_waitcnt vmcnt(0)" ::: "memory")
__device__ __forceinline__ unsigned long long rt() { return __builtin_amdgcn_s_memrealtime(); }
__device__ __forceinline__ unsigned f2bf(float f) { unsigned u = __builtin_bit_cast(unsigned, f); return (u + 0x7fffu + ((u >> 16) & 1u)) >> 16; }
__device__ __forceinline__ unsigned pk2(float lo, float hi) { return f2bf(lo) | (f2bf(hi) << 16); }
#define XB_TMO      128
#define XB_XCNT(j)  (256  + 64 * (j))
#define XB_XSUB(j)  (1280 + 64 * (j))
#define XB_XGEN(j)  (2304 + 64 * (j))
#define XB_TOP      3328
#define XB_TOPGEN   3392
#define XCD_BAR_WORDS 3456
#define XB_SPIN_CAP (1u << 18)

__device__ __forceinline__ unsigned xb_ld(unsigned* p)              { return __hip_atomic_load(p, __ATOMIC_RELAXED, __HIP_MEMORY_SCOPE_AGENT); }
__device__ __forceinline__ unsigned xb_add(unsigned* p, unsigned v) { return __hip_atomic_fetch_add(p, v, __ATOMIC_RELAXED, __HIP_MEMORY_SCOPE_AGENT); }
__device__ __forceinline__ unsigned xb_xcc_id() { return (unsigned)__builtin_amdgcn_s_getreg((3 << 11) | 20) & 0xFu; }
#define XB_SPIN(cond, bar) do { unsigned _sp = 0; while (cond) { __builtin_amdgcn_s_sleep(1); \
    if ((++_sp & 255u) == 0u) { if (xb_ld(&(bar)[XB_TMO])) break; if (_sp > XB_SPIN_CAP) { atomicAdd(&(bar)[XB_TMO], 1u); break; } } } } while (0)

struct XcdBarrier {
    unsigned* bar; unsigned x;
    volatile LAS unsigned* st;
};

__device__ __forceinline__ XcdBarrier xcd_barrier_post(unsigned* bar, volatile LAS unsigned* st) {
    XcdBarrier b; b.bar = bar; b.x = xb_xcc_id(); b.st = st;
    if (threadIdx.x == 0) (void)xb_add(&bar[XB_XCNT(b.x)], 1u);
    return b;
}
__device__ __forceinline__ void xcd_barrier_complete(unsigned* bar, unsigned x, unsigned& nloc, unsigned& nx) {
    const unsigned G = gridDim.x * gridDim.y * gridDim.z;
    unsigned sum, cnt, mine, sp = 0u;
    for (;;) {
        sum = 0u; cnt = 0u; mine = 0u;
#pragma unroll
        for (unsigned j = 0; j < 16; ++j) { const unsigned c = xb_ld(&bar[XB_XCNT(j)]); sum += c; cnt += (c > 0u) ? 1u : 0u; mine = (j == x) ? c : mine; }
        if (sum == G) break;
        __builtin_amdgcn_s_sleep(1);
        if ((++sp & 255u) == 0u) { if (xb_ld(&bar[XB_TMO])) break; if (sp > XB_SPIN_CAP) { atomicAdd(&bar[XB_TMO], 1u); break; } }
    }
    nloc = mine > 0u ? mine : 1u; nx = cnt > 0u ? cnt : 1u;
}

__device__ __forceinline__ void xcd_barrier(const XcdBarrier& b) {
    asm volatile("s_waitcnt vmcnt(0)" ::: "memory");
    __syncthreads();
    if (threadIdx.x == 0) {
        unsigned* bar = b.bar;
        __builtin_amdgcn_s_waitcnt(0);
        unsigned nloc = b.st[0], nx = b.st[1];
        if (nloc == 0u) { xcd_barrier_complete(bar, b.x, nloc, nx); b.st[0] = nloc; b.st[1] = nx; }
        const unsigned old = xb_add(&bar[XB_XSUB(b.x)], 1u);
        const unsigned gen = old / nloc;
        if (old + 1u == (gen + 1u) * nloc) {
            __builtin_amdgcn_fence(__ATOMIC_RELEASE, "agent");
            asm volatile("s_waitcnt vmcnt(0)" ::: "memory");
            const unsigned og = xb_add(&bar[XB_TOP], 1u);
            const unsigned tg = og / nx;
            if (og + 1u == (tg + 1u) * nx) xb_add(&bar[XB_TOPGEN], 1u);
            else XB_SPIN(xb_ld(&bar[XB_TOPGEN]) == tg, bar);
            __builtin_amdgcn_fence(__ATOMIC_ACQUIRE, "agent");
            xb_add(&bar[XB_XGEN(b.x)], 1u);
            asm volatile("s_waitcnt vmcnt(0)" ::: "memory");
        } else {
            XB_SPIN(xb_ld(&bar[XB_XGEN(b.x)]) == gen, bar);
            __builtin_amdgcn_fence(__ATOMIC_ACQUIRE, "agent");
            asm volatile("s_waitcnt vmcnt(0)" ::: "memory");
        }
    }
    __syncthreads();
}

constexpr int DM = 1024, NB = 8, SEQ = 4096, NMETA = 16, LTOK = SEQ + NMETA, PADF = 112, LP = LTOK + PADF, MROWS = NB * LP;
constexpr int NHEAD = 16, CONVD = 1280, NCHUNK = LP / 128;
constexpr int NEXP = 32, TCAP = NB * SEQ;
constexpr int VPROWS = 74240;
constexpr float EPS = 1e-6f;
constexpr float QSCALE = 0.10206207261596575f * 1.4426950408889634f;
static_assert(LP % 128 == 0 && MROWS % 256 == 0, "row geometry");

constexpr size_t MiB = 1u << 20;
constexpr size_t WS_CTL = 0, CTL_ZERO_BYTES = 1 * MiB;
constexpr size_t WS_WINA = 1 * MiB, WS_WINB = WS_WINA + 3584 * 1024, WS_WUQ = WS_WINB + 6 * MiB, WS_WUKV = WS_WUQ + 768 * 1024, WS_WBA = 12 * MiB, WS_WBS = 14 * MiB, WS_WOUT = 16 * MiB,
                 WS_WGU = 18 * MiB, WS_WD = 50 * MiB, WS_CS = 66 * MiB;
constexpr size_t WS_XN = 68 * MiB;
constexpr size_t WS_KV = 134 * MiB;
constexpr size_t WS_SA = WS_KV, WS_SS = WS_KV + 66 * MiB, WS_H1 = WS_KV;
constexpr size_t WS_XBC = 266 * MiB;
constexpr size_t WS_MRG = WS_XBC, WS_Z = WS_XBC;
constexpr size_t WS_DL = WS_H1;
constexpr size_t WS_Y = 349 * MiB;
constexpr size_t WS_CQ = 415 * MiB, WS_CKV = 432 * MiB, WS_KR = 441 * MiB, WS_DT = 444 * MiB, WS_SSQ = 447 * MiB, WS_SSKV = 448 * MiB, WS_KRF = 462 * MiB;
constexpr size_t WS_VP = 266 * MiB;
constexpr size_t WS_YP = WS_VP;
constexpr size_t WS_HM = 415 * MiB;
constexpr size_t WS_TOKW = 452 * MiB, WS_TOKE = 453 * MiB, WS_HIST = 454 * MiB, WS_CNTG = 455 * MiB, WS_PROW = 458 * MiB, WS_GIDX = 459 * MiB, WS_END = 460 * MiB;
static_assert(WS_WUKV + 2048 * 128 * 2 <= WS_WBA && WS_VP + (size_t)VPROWS * 2048 <= WS_HM && WS_HM + (size_t)VPROWS * 512 <= WS_TOKW, "ws map");

constexpr int CW_TMO = 0, CW_Q3 = 64, CW_CNT = 128, CW_BAR = 4096;

constexpr int RING_BYTES = 143360, MISC_OFF = RING_BYTES, LDS_BYTES = 147456;

typedef unsigned u32x2 __attribute__((ext_vector_type(2)));
__device__ __forceinline__ float bf2f(unsigned short b) { return __uint_as_float((unsigned)b << 16); }
__device__ __forceinline__ float bflo(unsigned u) { return __uint_as_float(u << 16); }
__device__ __forceinline__ float bfhi(unsigned u) { return __uint_as_float(u & 0xffff0000u); }
__device__ __forceinline__ float sigm(float x) { return __builtin_amdgcn_rcpf(1.f + __expf(-x)); }
__device__ __forceinline__ float silu(float x) { return x * __builtin_amdgcn_rcpf(1.f + __expf(-x)); }
__device__ __forceinline__ float wave_sum(float v) {
#pragma unroll
    for (int o = 1; o < 64; o <<= 1) v += __shfl_xor(v, o);
    return v;
}
__device__ __forceinline__ void st_bf4(bf16* p, f32x4 v) { u32x2 w; w.x = pk2(v[0], v[1]); w.y = pk2(v[2], v[3]); *(GAS u32x2*)p = w; }
__device__ __forceinline__ f32x4 ld_bf4(const bf16* p) { const u32x2 w = *(const GAS u32x2*)p; return (f32x4){bflo(w.x), bfhi(w.x), bflo(w.y), bfhi(w.y)}; }
__device__ __forceinline__ float add_x16(float s) { return s + __int_as_float(__builtin_amdgcn_ds_swizzle(__float_as_int(s), 0x401F)); }
__device__ __forceinline__ float add_x32(float s) { const auto rr = __builtin_amdgcn_permlane32_swap(__float_as_uint(s), __float_as_uint(s), false, false); return __uint_as_float(rr[0]) + __uint_as_float(rr[1]); }
__device__ __forceinline__ int row_tok(int row, int& b) { b = (int)(((float)row + 0.5f) * (1.0f / (float)LP)); return row - b * LP - PADF; }

using pg8::Unit;
typedef float f32x2_t __attribute__((ext_vector_type(2)));
typedef __bf16 bf16x2_t __attribute__((ext_vector_type(2)));
__device__ __forceinline__ unsigned cvtpk(float lo, float hi) { f32x2_t v = {lo, hi}; bf16x2_t b = __builtin_convertvector(v, bf16x2_t); return __builtin_bit_cast(unsigned, b); }
__device__ __forceinline__ void st_bf8(bf16* p, f32x4 a, f32x4 b) { *(GAS v4u*)p = (v4u){cvtpk(a[0], a[1]), cvtpk(a[2], a[3]), cvtpk(b[0], b[1]), cvtpk(b[2], b[3])}; }
__device__ __forceinline__ void ld_bf8(const bf16* p, f32x4& a, f32x4& b) { const v4u w = *(const GAS v4u*)p; a = (f32x4){bflo(w.x), bfhi(w.x), bflo(w.y), bfhi(w.y)}; b = (f32x4){bflo(w.z), bfhi(w.z), bflo(w.w), bfhi(w.w)}; }
#define EPI_ROWS(ai, m) (u.pm * 128 + (ai) * 128 + wr * 64 + (m) * 16 + fr)
#define EPI_C8(bj) ((bj) * 128 + wc * 32 + fq * 8)
#define EPI_LANE unsigned on_ = ~0u; asm volatile("" : "+s"(on_)); const int ln_ = (int)__builtin_amdgcn_mbcnt_hi(on_, __builtin_amdgcn_mbcnt_lo(on_, 0u)); const int fr = ln_ & 15, fq = ln_ >> 4; (void)fr_; (void)fq_;
#define EPI_SUMSQ(v) (((v)[0] * (v)[0] + (v)[1] * (v)[1]) + ((v)[2] * (v)[2] + (v)[3] * (v)[3]))

struct EpiInA {
    static constexpr bool PERM = true, AFTER_DRAIN = false;
    bf16 *CQ, *CKV, *XBC; float *KRF, *DT, *SSQ, *SSKV;
    __device__ __forceinline__ void operator()(const f32x4 (&acc)[2][2][4][2], const Unit& u, int wr, int wc, int fr_, int fq_) const {
        EPI_LANE
        const int pn = u.pn;
        if (pn == 0) {
#pragma unroll
            for (int ai = 0; ai < 2; ++ai)
#pragma unroll
                for (int m = 0; m < 4; ++m) { const int row = EPI_ROWS(ai, m); float s = 0.f;
#pragma unroll
                    for (int bj = 0; bj < 2; ++bj) { st_bf8(CQ + (size_t)row * 256 + EPI_C8(bj), acc[ai][bj][m][0], acc[ai][bj][m][1]); s += EPI_SUMSQ(acc[ai][bj][m][0]) + EPI_SUMSQ(acc[ai][bj][m][1]); }
                    s = add_x16(s); s = add_x32(s);
                    if (fq == 0) SSQ[(size_t)row * 4 + wc] = s; asm volatile("" ::: "memory"); }
        } else if (pn == 1) {
#pragma unroll
            for (int ai = 0; ai < 2; ++ai)
#pragma unroll
                for (int m = 0; m < 4; ++m) { const int row = EPI_ROWS(ai, m);
                    st_bf8(CKV + (size_t)row * 128 + wc * 32 + fq * 8, acc[ai][0][m][0], acc[ai][0][m][1]);
                    float s = EPI_SUMSQ(acc[ai][0][m][0]) + EPI_SUMSQ(acc[ai][0][m][1]);
                    s = add_x16(s); s = add_x32(s);
                    if (fq == 0) SSKV[(size_t)row * 4 + wc] = s;
                    if (wc == 0) { float* kp = KRF + (size_t)row * 32 + fq * 8; *(f32x4*)kp = acc[ai][1][m][0]; *(f32x4*)(kp + 4) = acc[ai][1][m][1]; }
                    else if (wc == 1 && fq < 2) { float* dp = DT + (size_t)row * 16 + fq * 8; *(f32x4*)dp = acc[ai][1][m][0]; *(f32x4*)(dp + 4) = acc[ai][1][m][1]; }
                    asm volatile("" ::: "memory"); }
        } else {
            const int cb = (pn - 2) * 256;
#pragma unroll
            for (int ai = 0; ai < 2; ++ai)
#pragma unroll
                for (int m = 0; m < 4; ++m) { const int row = EPI_ROWS(ai, m);
#pragma unroll
                    for (int bj = 0; bj < 2; ++bj) st_bf8(XBC + (size_t)row * CONVD + cb + EPI_C8(bj), acc[ai][bj][m][0], acc[ai][bj][m][1]); }
        }
    }
};

struct EpiQ {
    static constexpr bool PERM = true, AFTER_DRAIN = false;
    bf16 *Qn, *Qr; const float *SSQ, *CS;
    __device__ __forceinline__ void operator()(const f32x4 (&acc)[2][2][4][2], const Unit& u, int wr, int wc, int fr_, int fq_) const {
        EPI_LANE
        const int pn = u.pn;
#pragma unroll
        for (int ai = 0; ai < 2; ++ai)
#pragma unroll
            for (int m = 0; m < 4; ++m) { const int row = EPI_ROWS(ai, m);
                const f32x4 p = *(const f32x4*)(SSQ + (size_t)row * 4); const float rs = rsqrtf(((p[0] + p[1]) + (p[2] + p[3])) * (1.f / 256.f) + EPS);
                if (pn < 4) {
#pragma unroll
                    for (int bj = 0; bj < 2; ++bj) st_bf8(Qn + (size_t)row * 1024 + pn * 256 + EPI_C8(bj), acc[ai][bj][m][0] * rs, acc[ai][bj][m][1] * rs);
                } else {
                    int b; const int tok = row_tok(row, b);
                    const int jj = (fq & 1) * 8; const float sg = fq < 2 ? -1.f : 1.f;
                    f32x4 c0 = (f32x4){0.f, 0.f, 0.f, 0.f}, c1 = c0, s0 = c0, s1 = c0;
                    if (tok >= 0) { const float* cs = CS + (size_t)tok * 32 + jj; c0 = *(const f32x4*)cs; c1 = *(const f32x4*)(cs + 4); s0 = *(const f32x4*)(cs + 16) * sg; s1 = *(const f32x4*)(cs + 20) * sg; }
                    const int paddr = (ln_ ^ 32) << 2;
#pragma unroll
                    for (int bj = 0; bj < 2; ++bj) { const f32x4 x0 = acc[ai][bj][m][0] * rs, x1 = acc[ai][bj][m][1] * rs; f32x4 y0, y1;
#pragma unroll
                        for (int i = 0; i < 4; ++i) { y0[i] = __int_as_float(__builtin_amdgcn_ds_bpermute(paddr, __float_as_int(x0[i]))); y1[i] = __int_as_float(__builtin_amdgcn_ds_bpermute(paddr, __float_as_int(x1[i]))); }
                        st_bf8(Qr + (size_t)row * 512 + (pn - 4) * 256 + EPI_C8(bj), x0 * c0 + y0 * s0, x1 * c1 + y1 * s1); }
                } asm volatile("" ::: "memory"); }
    }
};
struct EpiKV {
    static constexpr bool PERM = true, AFTER_DRAIN = false;
    bf16* KV; const float* SSKV;
    __device__ __forceinline__ void operator()(const f32x4 (&acc)[2][2][4][2], const Unit& u, int wr, int wc, int fr_, int fq_) const {
        EPI_LANE
        float rs[8];
#pragma unroll
        for (int i = 0; i < 8; ++i) { const f32x4 p = *(const f32x4*)(SSKV + (size_t)EPI_ROWS(i >> 2, i & 3) * 4); rs[i] = rsqrtf(((p[0] + p[1]) + (p[2] + p[3])) * (1.f / 128.f) + EPS); }
#pragma unroll
        for (int ai = 0; ai < 2; ++ai)
#pragma unroll
            for (int m = 0; m < 4; ++m) { const int row = EPI_ROWS(ai, m); const float r1 = rs[ai * 4 + m];
#pragma unroll
                for (int bj = 0; bj < 2; ++bj) st_bf8(KV + (size_t)row * 2048 + u.pn * 256 + EPI_C8(bj), acc[ai][bj][m][0] * r1, acc[ai][bj][m][1] * r1); }
    }
};
struct EpiZG {
    static constexpr bool PERM = true, AFTER_DRAIN = false;
    bf16 *Z, *SA, *SS;
    __device__ __forceinline__ void operator()(const f32x4 (&acc)[2][2][4][2], const Unit& u, int wr, int wc, int fr_, int fq_) const {
        EPI_LANE
        const int pn = u.pn;
#pragma unroll
        for (int ai = 0; ai < 2; ++ai)
#pragma unroll
            for (int m = 0; m < 4; ++m) { const int row = EPI_ROWS(ai, m);
#pragma unroll
                for (int bj = 0; bj < 2; ++bj) { const f32x4 z0 = acc[ai][bj][m][0], z1 = acc[ai][bj][m][1]; const int c8 = EPI_C8(bj);
                    if (pn < 4) st_bf8(Z + (size_t)row * 1024 + pn * 256 + c8, (f32x4){silu(z0[0]), silu(z0[1]), silu(z0[2]), silu(z0[3])}, (f32x4){silu(z1[0]), silu(z1[1]), silu(z1[2]), silu(z1[3])});
                    else { bf16* gp = (pn < 8 ? SA + (size_t)row * 1024 + (pn - 4) * 256 : SS + (size_t)row * 1024 + (pn - 8) * 256) + c8;
                        st_bf8(gp, (f32x4){sigm(z0[0]), sigm(z0[1]), sigm(z0[2]), sigm(z0[3])}, (f32x4){sigm(z1[0]), sigm(z1[1]), sigm(z1[2]), sigm(z1[3])}); } } }
    }
};
template <int SECOND> struct EpiBr {
    static constexpr bool PERM = true, AFTER_DRAIN = false;
    bf16* MRG; const bf16* G;
    __device__ __forceinline__ void operator()(const f32x4 (&acc)[2][2][4][2], const Unit& u, int wr, int wc, int fr_, int fq_) const {
        EPI_LANE
#pragma unroll
        for (int ai = 0; ai < 2; ++ai)
#pragma unroll
            for (int m = 0; m < 4; ++m) { const int row = EPI_ROWS(ai, m);
#pragma unroll
                for (int bj = 0; bj < 2; ++bj) { const size_t o = (size_t)row * 1024 + u.pn * 256 + EPI_C8(bj); f32x4 g0, g1; ld_bf8(G + o, g0, g1);
                    f32x4 v0 = g0 * acc[ai][bj][m][0], v1 = g1 * acc[ai][bj][m][1];
                    if (SECOND) { f32x4 m0, m1; ld_bf8(MRG + o, m0, m1); v0 += m0; v1 += m1; }
                    st_bf8(MRG + o, v0, v1); } }
    }
};
struct EpiOut {
    static constexpr bool PERM = true, AFTER_DRAIN = false;
    bf16* DL;
    __device__ __forceinline__ void operator()(const f32x4 (&acc)[2][2][4][2], const Unit& u, int wr, int wc, int fr_, int fq_) const {
        EPI_LANE
#pragma unroll
        for (int ai = 0; ai < 2; ++ai)
#pragma unroll
            for (int m = 0; m < 4; ++m) { const int row = EPI_ROWS(ai, m);
#pragma unroll
                for (int bj = 0; bj < 2; ++bj) st_bf8(DL + (size_t)row * 1024 + u.pn * 256 + EPI_C8(bj), acc[ai][bj][m][0], acc[ai][bj][m][1]); }
    }
};
struct EpiGU {
    static constexpr bool PERM = true, AFTER_DRAIN = false;
    bf16* HM;
    __device__ __forceinline__ void operator()(const f32x4 (&acc)[2][2][4][2], const Unit& u, int wr, int wc, int fr_, int fq_) const {
        EPI_LANE
        const int j = u.pn & 1;
#pragma unroll
        for (int ai = 0; ai < 2; ++ai)
#pragma unroll
            for (int m = 0; m < 4; ++m) { const int row = EPI_ROWS(ai, m);
                const f32x4 g0 = acc[ai][0][m][0], g1 = acc[ai][0][m][1], u0 = acc[ai][1][m][0], u1 = acc[ai][1][m][1];
                st_bf8(HM + (size_t)row * 256 + j * 128 + wc * 32 + fq * 8, (f32x4){silu(g0[0]) * u0[0], silu(g0[1]) * u0[1], silu(g0[2]) * u0[2], silu(g0[3]) * u0[3]},
                       (f32x4){silu(g1[0]) * u1[0], silu(g1[1]) * u1[1], silu(g1[2]) * u1[2], silu(g1[3]) * u1[3]}); }
    }
};
struct EpiDown {
    static constexpr bool PERM = true, AFTER_DRAIN = false;
    bf16* YP; const int* PROW; const float* TOKW;
    __device__ __forceinline__ void operator()(const f32x4 (&acc)[2][2][4][2], const Unit& u, int wr, int wc, int fr_, int fq_) const {
        EPI_LANE
        const int j = u.pn & 3;
        int code[8];
#pragma unroll
        for (int i = 0; i < 8; ++i) code[i] = PROW[EPI_ROWS(i >> 2, i & 3)];
#pragma unroll
        for (int ai = 0; ai < 2; ++ai) { float w[4];
#pragma unroll
            for (int m = 0; m < 4; ++m) w[m] = TOKW[code[ai * 4 + m] < 0 ? 0 : code[ai * 4 + m]];
#pragma unroll
            for (int m = 0; m < 4; ++m) { const int cd = code[ai * 4 + m];
                if (cd >= 0) { const float ww = w[m]; bf16* dst = YP + ((size_t)(cd & 1) * MROWS + (cd >> 1)) * 1024 + j * 256;
#pragma unroll
                    for (int bj = 0; bj < 2; ++bj) st_bf8(dst + EPI_C8(bj), acc[ai][bj][m][0] * ww, acc[ai][bj][m][1] * ww); } } }
    }
};
struct MoeOrder {
    const LAS int* ost;
    int ncol, G, c;
    __device__ __forceinline__ bool next(int i, Unit& u) const {
        const int L = i * G + c, ntile = __builtin_amdgcn_readfirstlane(ost[NEXP] >> 8);
        if (L >= ntile * ncol) return false;
        const int rt = L / ncol, j = L - rt * ncol; int e = 0;
        for (int k = 1; k < NEXP; ++k) e += ((ost[k] >> 8) <= rt) ? 1 : 0;
        u.pm = __builtin_amdgcn_readfirstlane(2 * rt); u.pn = __builtin_amdgcn_readfirstlane(e * ncol + j); return true;
    }
    __device__ __forceinline__ void a_ready(const Unit&) const {}
    __device__ __forceinline__ void done(const Unit&) const {}
};

struct StdOrder {
    pg8::StaticOrder so;
    __device__ __forceinline__ void init(int M, int N, int G, int c) { so.init(M, N, G, c); }
    __device__ __forceinline__ bool next(int i, Unit& u) const { if (!so.next(i, u)) return false; u.pm *= 2; return true; }
    __device__ __forceinline__ void a_ready(const Unit&) const {}
    __device__ __forceinline__ void done(const Unit&) const {}
};
struct TokOrder {
    pg8::StaticOrder so;
    __device__ __forceinline__ void init(int N, int G, int c) { so.init(NB * SEQ, N, G, c); }
    __device__ __forceinline__ bool next(int i, Unit& u) const { if (!so.next(i, u)) return false; u.pm = 33 * (u.pm >> 4) + 1 + 2 * (u.pm & 15); return true; }
    __device__ __forceinline__ void a_ready(const Unit&) const {}
    __device__ __forceinline__ void done(const Unit&) const {}
};

__device__ __forceinline__ void tr_item(const float* __restrict__ W, int ldw, int sc0, int nvalid, int k0, const float* __restrict__ ks, float mul, bf16* WT, int K, int dn0, LAS float* scr, int lane) {
    (void)scr; const int n = lane & 31, kh = lane >> 5; const bool ok = n < nvalid;
    const float* src = W + (size_t)(k0 + 32 * kh) * ldw + sc0 + n; bf16* dst = WT + (size_t)(dn0 + n) * K + k0 + 32 * kh;
    float v[32];
#pragma unroll
    for (int j = 0; j < 32; ++j) v[j] = ok ? src[(size_t)j * ldw] : 0.f;
    if (ks) {
#pragma unroll
        for (int j = 0; j < 32; ++j) v[j] *= ks[k0 + 32 * kh + j]; }
#pragma unroll
    for (int kb = 0; kb < 4; ++kb) *(v4u*)(dst + 8 * kb) = (v4u){cvtpk(v[8 * kb] * mul, v[8 * kb + 1] * mul), cvtpk(v[8 * kb + 2] * mul, v[8 * kb + 3] * mul), cvtpk(v[8 * kb + 4] * mul, v[8 * kb + 5] * mul), cvtpk(v[8 * kb + 6] * mul, v[8 * kb + 7] * mul)};
}

struct In {
    const float *x, *meta, *norm_mix, *w_in, *q_norm, *w_uq, *kv_norm, *w_ukv, *conv_w, *conv_b, *dt_bias, *a_log, *d_skip, *ssm_norm, *w_ba, *w_bs, *w_out, *norm_ffn,
                *w_group, *b_group, *w_expert, *b_expert, *w_gate, *w_up, *w_down, *norm_final;
};

constexpr int P0_NIT = 16 * 56 + 16 * 96 + 4 * 48 + 2 * 64 + 3 * 16 * 32 + 16 * 512 + 4 * 1024;
constexpr int P0_Q_N = 1536 + 1536 + 2600, P0_GU1 = 4288 + 2600, P0_MOVE1 = 3800, P0_GU3 = P0_GU1 + P0_MOVE1, P0_D0 = 12480;
static_assert(P0_NIT == 16576 && P0_GU3 < P0_D0, "item ranges");
__device__ __forceinline__ void p0_items(const In& I, unsigned char* ws, LAS unsigned char* lds, int it0, int it1, int w, int nw, int wave, int lane) {
    LAS float* scr = (LAS float*)(lds + wave * 16384);
    bf16 *WinA = (bf16*)(ws + WS_WINA), *WinB = (bf16*)(ws + WS_WINB), *Wuq = (bf16*)(ws + WS_WUQ), *Wukv = (bf16*)(ws + WS_WUKV), *Wba = (bf16*)(ws + WS_WBA), *Wbs = (bf16*)(ws + WS_WBS),
         *Wout = (bf16*)(ws + WS_WOUT), *Wgu = (bf16*)(ws + WS_WGU), *Wd = (bf16*)(ws + WS_WD);
    constexpr int I_A = 16 * 56, I_B = 16 * 96, I_UQ = 4 * 48, I_UKV = 2 * 64, I_SQ = 16 * 32, I_GU = 16 * 512, I_D = 4 * 1024;
    constexpr int NIT = I_A + I_B + I_UQ + I_UKV + 3 * I_SQ + I_GU + I_D;
    for (int it = it0 + w; it < it1; it += nw) {
        int r = it;
        if (r < I_A) { const int kb = r / 56, n0 = (r % 56) * 32; int sc0 = 0, nv = 32;
            if (n0 < 416) sc0 = n0; else if (n0 == 416) { sc0 = 2720; nv = 16; } else if (n0 < 512) { sc0 = 0; nv = 0; } else sc0 = 1440 + (n0 - 512);
            tr_item(I.w_in, 4784, sc0, nv, kb * 64, nullptr, 1.f, WinA, 1024, n0, scr, lane); continue; }
        r -= I_A;
        if (r < I_B) { const int kb = r / 96, n0 = (r % 96) * 32; const int sc0 = n0 < 1024 ? 416 + n0 : (n0 < 2048 ? 2736 + (n0 - 1024) : 3760 + (n0 - 2048));
            tr_item(I.w_in, 4784, sc0, 32, kb * 64, nullptr, 1.f, WinB, 1024, n0, scr, lane); continue; }
        r -= I_B;
        if (r < I_UQ) { const int kb = r / 48, n0 = (r % 48) * 32; const int sc0 = n0 < 1024 ? 96 * (n0 / 64) + (n0 % 64) : 96 * ((n0 - 1024) / 32) + 64;
            tr_item(I.w_uq, 1536, sc0, 32, kb * 64, I.q_norm, QSCALE, Wuq, 256, n0, scr, lane); continue; }
        r -= I_UQ;
        if (r < I_UKV) { const int kb = r / 64, n0 = (r % 64) * 32; tr_item(I.w_ukv, 2048, n0, 32, kb * 64, I.kv_norm, 1.f, Wukv, 128, n0, scr, lane); continue; }
        r -= I_UKV;
        if (r < I_SQ) { const int kb = r / 32, n0 = (r % 32) * 32; tr_item(I.w_ba, 1024, n0, 32, kb * 64, nullptr, 1.f, Wba, 1024, n0, scr, lane); continue; }
        r -= I_SQ;
        if (r < I_SQ) { const int kb = r / 32, n0 = (r % 32) * 32; tr_item(I.w_bs, 1024, n0, 32, kb * 64, I.ssm_norm, 1.f, Wbs, 1024, n0, scr, lane); continue; }
        r -= I_SQ;
        if (r < I_SQ) { const int kb = r / 32, n0 = (r % 32) * 32; tr_item(I.w_out, 1024, n0, 32, kb * 64, nullptr, 1.f, Wout, 1024, n0, scr, lane); continue; }
        r -= I_SQ;
        if (r < I_GU) { const int kb = r / 512, n0 = (r % 512) * 32; const int e = n0 / 512, rr = n0 % 512, j = rr / 256, half = (rr % 256) / 128, c = rr % 128;
            const float* W = (half ? I.w_up : I.w_gate) + (size_t)e * 1024 * 256;
            tr_item(W, 256, 128 * j + c, 32, kb * 64, nullptr, 1.f, Wgu, 1024, n0, scr, lane); continue; }
        r -= I_GU;
        { const int kb = r / 1024, n0 = (r % 1024) * 32; const int e = n0 / 1024; const float* W = I.w_down + (size_t)e * 256 * 1024;
            tr_item(W, 1024, n0 % 1024, 32, kb * 64, nullptr, 1.f, Wd, 256, n0, scr, lane); }
    }
}
template <int PARTS = 7> __device__ __forceinline__ void p0_prologue(const In& I, unsigned char* ws, LAS unsigned char* lds, int gw, int NGW, int wave, int lane) {
    if (PARTS & 1) { p0_items(I, ws, lds, 0, 896, gw, NGW, wave, lane); p0_items(I, ws, lds, 2432, 2752, (gw + 896) % NGW, NGW, wave, lane); }
    float* CS = (float*)(ws + WS_CS);
    if (PARTS & 2) for (int idx = gw * 64 + lane; idx < LTOK * 16; idx += NGW * 64) { const int pos = idx >> 4, j = idx & 15;
        const float inv = exp2f(-(float)j * (13.287712379549449f / 16.f)); const float ang = (float)pos * inv;
        const double a = (double)ang; const double kk = rint(a * 0.15915494309189535); const float rr = (float)(a - kk * 6.283185307179586);
        CS[pos * 32 + j] = __cosf(rr); CS[pos * 32 + 16 + j] = __sinf(rr); }
    bf16* XN = (bf16*)(ws + WS_XN);
    f32x4 gm[4];
#pragma unroll
    for (int j = 0; j < 4; ++j) gm[j] = ((const f32x4*)I.norm_mix)[lane + 64 * j];
    if (PARTS & 4) for (int row0 = NGW - 1 - gw; row0 < MROWS; row0 += 2 * NGW) {
        const int row1 = row0 + NGW; const bool has1 = row1 < MROWS;
        int b0, b1; const int tok0 = row_tok(row0, b0), tok1 = has1 ? row_tok(row1, b1) : -1;
        const float* s0 = tok0 < 0 ? nullptr : (tok0 < NMETA ? I.meta + (size_t)tok0 * DM : I.x + ((size_t)b0 * SEQ + (tok0 - NMETA)) * DM);
        const float* s1 = tok1 < 0 ? nullptr : (tok1 < NMETA ? I.meta + (size_t)tok1 * DM : I.x + ((size_t)b1 * SEQ + (tok1 - NMETA)) * DM);
        f32x4 v0[4], v1[4];
#pragma unroll
        for (int j = 0; j < 4; ++j) { v0[j] = s0 ? __builtin_nontemporal_load((const f32x4*)s0 + lane + 64 * j) : (f32x4){0.f, 0.f, 0.f, 0.f}; v1[j] = s1 ? __builtin_nontemporal_load((const f32x4*)s1 + lane + 64 * j) : (f32x4){0.f, 0.f, 0.f, 0.f}; }
#define XN_ROW(V, ROW) do { float s = 0.f; \
        _Pragma("unroll") for (int j = 0; j < 4; ++j) s += (V[j][0] * V[j][0] + V[j][1] * V[j][1]) + (V[j][2] * V[j][2] + V[j][3] * V[j][3]); \
        const float rs = rsqrtf(wave_sum(s) * (1.f / DM) + EPS); unsigned long long* o8 = (unsigned long long*)(XN + (size_t)(ROW) * DM) + lane; \
        _Pragma("unroll") for (int j = 0; j < 4; ++j) { const f32x4 t = V[j] * rs * gm[j]; o8[64 * j] = (unsigned long long)cvtpk(t[0], t[1]) | ((unsigned long long)cvtpk(t[2], t[3]) << 32); } } while (0)
        XN_ROW(v0, row0);
        if (has1) XN_ROW(v1, row1);
#undef XN_ROW
    }
}

#define LDS_BARRIER() asm volatile("s_waitcnt lgkmcnt(0)\n\ts_barrier" ::: "memory")
#ifdef PRB_USEG
#define TU(k, LDSP) do { if ((k) == PRB_USEG || (k) == PRB_USEG2) { const unsigned now_ = (unsigned)wall_clock64(); const int wv_ = __builtin_amdgcn_readfirstlane((int)(threadIdx.x >> 6)); \
        if ((threadIdx.x & 63) == 0) { volatile LAS unsigned* m_ = (volatile LAS unsigned*)((LDSP) + MISC_OFF); if ((k) == PRB_USEG) m_[48 + wv_] = now_; else (void)__hip_atomic_fetch_add((LAS unsigned*)((LDSP) + MISC_OFF + 40), now_ - m_[48 + wv_], __ATOMIC_RELAXED, __HIP_MEMORY_SCOPE_WORKGROUP); } } } while (0)
#else
#define TU(k, LDSP) do { } while (0)
#endif
typedef float f32x16 __attribute__((ext_vector_type(16)));
__device__ __forceinline__ v4u pack_rowpair(float a0, float a1, float a2, float a3, float c0, float c1, float c2, float c3) {
    const unsigned w0 = cvtpk(a0, a1), w1 = cvtpk(a2, a3), y0 = cvtpk(c0, c1), y1 = cvtpk(c2, c3);
    const auto s0 = __builtin_amdgcn_permlane32_swap(w0, y0, false, false); const auto s1 = __builtin_amdgcn_permlane32_swap(w1, y1, false, false);
    return (v4u){(unsigned)s0[0], (unsigned)s1[0], (unsigned)s0[1], (unsigned)s1[1]};
}
typedef short v4i16_t __attribute__((ext_vector_type(4)));
constexpr int AT_KP = 208, AT_VP = 144, AT_KB = 64 * AT_KP, AT_VB = 64 * AT_VP, AT_GRP = AT_KB + AT_VB, AT_BUF = 2 * AT_GRP;
__device__ __forceinline__ void attn_unit(int b, int hp, int j, const bf16* Qn, const bf16* Qr, const bf16* KV, const bf16* KR, bf16* Oout, unsigned omask, LAS unsigned char* lds, int tid) {
    asm volatile("" : "+v"(tid));
    const int lane = tid & 63, wave = __builtin_amdgcn_readfirstlane(tid >> 6), grp = wave >> 2, wq = wave & 3, r = lane & 31, hh = lane >> 5;
    const int h = 2 * hp + grp, tg = tid & 255;
    LAS unsigned char* Kt = lds + grp * AT_GRP; LAS unsigned char* Vt = Kt + AT_KB;
    const size_t rowb = (size_t)b * LP; const int R0 = 256 * j - 128 + 64 * wq; const int pqA = R0 + r, pqB = pqA + 32;
    const int last = 4 * j + 1, tmax = 4 * j + wq - 2;
    bf16x8 qfA[6], qfB[6];
    { const size_t ra = rowb + (pqA < 0 ? 0 : pqA), rb = rowb + (pqB < 0 ? 0 : pqB);
      const GAS bf16* qa = (const GAS bf16*)(Qn + ra * 1024 + h * 64 + 8 * hh); const GAS bf16* qb_ = (const GAS bf16*)(Qn + rb * 1024 + h * 64 + 8 * hh);
#pragma unroll
      for (int ks = 0; ks < 4; ++ks) { qfA[ks] = *(const GAS bf16x8*)(qa + 16 * ks); qfB[ks] = *(const GAS bf16x8*)(qb_ + 16 * ks); }
      const GAS bf16* pa = (const GAS bf16*)(Qr + ra * 512 + h * 32 + 8 * hh); const GAS bf16* pb_ = (const GAS bf16*)(Qr + rb * 512 + h * 32 + 8 * hh);
      qfA[4] = *(const GAS bf16x8*)pa; qfA[5] = *(const GAS bf16x8*)(pa + 16); qfB[4] = *(const GAS bf16x8*)pb_; qfB[5] = *(const GAS bf16x8*)(pb_ + 16); }
    const int k0 = tg >> 3, part = tg & 7;
    const __amdgpu_buffer_rsrc_t rkv = __builtin_amdgcn_make_buffer_rsrc((void*)(KV + rowb * 2048 + h * 128), 0, 0x7fffffff, 0x00020000);
    const __amdgpu_buffer_rsrc_t rkr = __builtin_amdgcn_make_buffer_rsrc((void*)(KR + rowb * 32), 0, 0x7fffffff, 0x00020000);
    const unsigned vok = (unsigned)(k0 * 4096 + part * 16), vor = (unsigned)((tg >> 2) * 64 + (tg & 3) * 16);
    LAS unsigned char* sk = Kt + k0 * AT_KP + part * 16; LAS unsigned char* sr = Kt + (tg >> 2) * AT_KP + 128 + (tg & 3) * 16; LAS unsigned char* sv = Vt + k0 * AT_VP + part * 16;
    v4u nk0, nk1, nr, nv0, nv1;
#define AT_LOAD(kt) do { const int so_ = (kt) * (64 * 4096), sr_ = (kt) * (64 * 64); \
        nk0 = __builtin_amdgcn_raw_buffer_load_b128(rkv, vok, so_, 0); nk1 = __builtin_amdgcn_raw_buffer_load_b128(rkv, vok, so_ + 32 * 4096, 0); nr = __builtin_amdgcn_raw_buffer_load_b128(rkr, vor, sr_, 0); \
        nv0 = __builtin_amdgcn_raw_buffer_load_b128(rkv, vok + 128, so_, 0); nv1 = __builtin_amdgcn_raw_buffer_load_b128(rkv, vok + 128, so_ + 32 * 4096, 0); } while (0)
#define AT_STORE(bo) do { *(LAS v4u*)(sk + (bo)) = nk0; *(LAS v4u*)(sk + (bo) + 32 * AT_KP) = nk1; *(LAS v4u*)(sr + (bo)) = nr; *(LAS v4u*)(sv + (bo)) = nv0; *(LAS v4u*)(sv + (bo) + 32 * AT_VP) = nv1; } while (0)
#define SBAR() __builtin_amdgcn_sched_barrier(0)
#define PIN(x) asm volatile("" : "+v"(x))
#define MF(a, b, c) __builtin_amdgcn_mfma_f32_32x32x16_bf16(a, b, c, 0, 0, 0)
#define MX3(a, b, c) __builtin_fmaxf(__builtin_fmaxf((a), (b)), (c))
#define RMAX16(p) ({ float a_ = MX3(p[0], p[1], p[2]), b_ = MX3(p[3], p[4], p[5]); a_ = MX3(a_, p[6], p[7]); b_ = MX3(b_, p[8], p[9]); a_ = MX3(a_, p[10], p[11]); b_ = MX3(b_, p[12], p[13]); a_ = MX3(a_, p[14], p[15]); __builtin_fmaxf(a_, b_); })
#define XMAX(m) ({ const auto rr_ = __builtin_amdgcn_permlane32_swap(__float_as_uint(m), __float_as_uint(m), false, false); __builtin_fmaxf(__uint_as_float(rr_[0]), __uint_as_float(rr_[1])); })
#define KRD(ks, hf) (*(const LAS bf16x8*)(ka + bo + (hf) * 32 * AT_KP + 32 * (ks)))
#define VRD(s, db) ({ const LAS unsigned char* vp_ = va + bo + (16 * (s)) * AT_VP + 64 * (db); const v4i16_t lo_ = __builtin_amdgcn_ds_read_tr16_b64_v4i16((LAS v4i16_t*)vp_), hi_ = __builtin_amdgcn_ds_read_tr16_b64_v4i16((LAS v4i16_t*)(vp_ + 8 * AT_VP)); \
        (bf16x8){lo_[0], lo_[1], lo_[2], lo_[3], hi_[0], hi_[1], hi_[2], hi_[3]}; })
#define MASKH(P, PQ, koff) do { const int kbase_ = 64 * kt + 4 * hh + (koff); _Pragma("unroll") for (int i = 0; i < 16; ++i) { const int kp_ = kbase_ + (i & 3) + 8 * (i >> 2); if (!(kp_ >= PADF && kp_ <= PQ)) P[i] = -1e30f; } } while (0)
#define EX4(P, i, M, S0, S1, WLO, WHI) do { P[i] = __builtin_amdgcn_exp2f(P[i] - M); P[i + 1] = __builtin_amdgcn_exp2f(P[i + 1] - M); P[i + 2] = __builtin_amdgcn_exp2f(P[i + 2] - M); P[i + 3] = __builtin_amdgcn_exp2f(P[i + 3] - M); \
        S0 += P[i]; S1 += P[i + 1]; S0 += P[i + 2]; S1 += P[i + 3]; WLO = cvtpk(P[i], P[i + 1]); WHI = cvtpk(P[i + 2], P[i + 3]); PIN(S0); PIN(S1); AT_DUMMY(P, i); } while (0)
#define BF8(w) __builtin_bit_cast(bf16x8, w)
#ifdef PRB_VALU
    float dmy0 = 0.f, dmy1 = 0.f;
#define AT_DUMMY(P, i) do { dmy0 += P[i]; dmy1 += P[i + 1]; dmy0 += P[i + 2]; dmy1 += P[i + 3]; PIN(dmy0); PIN(dmy1); } while (0)
#else
#define AT_DUMMY(P, i) do { } while (0)
#endif
    constexpr float AT_THR = 8.f;
    const f32x16 Z16 = {0.f, 0.f, 0.f, 0.f, 0.f, 0.f, 0.f, 0.f, 0.f, 0.f, 0.f, 0.f, 0.f, 0.f, 0.f, 0.f};
    f32x16 oA0, oA1, oB0, oB1;
#pragma unroll
    for (int i = 0; i < 16; ++i) { oA0[i] = 0.f; oA1[i] = 0.f; oB0[i] = 0.f; oB1[i] = 0.f; }
    float mA = -20000.f, lA = 0.f, mB = -20000.f, lB = 0.f;
    const LAS unsigned char* ka = Kt + r * AT_KP + 16 * hh;
    const LAS unsigned char* va = Vt + (4 * hh + ((lane & 15) >> 2)) * AT_VP + (16 * ((lane >> 4) & 1) + 4 * (lane & 3)) * 2;
    AT_LOAD(1);
    __syncthreads();
    AT_STORE(0);
    if (last > 1) AT_LOAD(2);
    int bo = 0;
    TU(2, lds);
    f32x16 pB1; v4u wA2, wA3; bf16x8 vf4, vf5, vf6, vf7; bool prev = false;
#define AT_S4() do { float sa_ = 0.f, sb_ = 0.f; v4u wB2, wB3; \
        oA0 = MF(vf4, BF8(wA2), oA0); EX4(pB1, 0, mB, sa_, sb_, wB2.x, wB2.y); SBAR(); \
        oA1 = MF(vf5, BF8(wA2), oA1); EX4(pB1, 4, mB, sa_, sb_, wB2.z, wB2.w); PIN(wB2); SBAR(); \
        oA0 = MF(vf6, BF8(wA3), oA0); EX4(pB1, 8, mB, sa_, sb_, wB3.x, wB3.y); SBAR(); \
        oA1 = MF(vf7, BF8(wA3), oA1); EX4(pB1, 12, mB, sa_, sb_, wB3.z, wB3.w); PIN(wB3); lB += sa_ + sb_; SBAR(); \
        oB0 = MF(vf4, BF8(wB2), oB0); oB1 = MF(vf5, BF8(wB2), oB1); oB0 = MF(vf6, BF8(wB3), oB0); oB1 = MF(vf7, BF8(wB3), oB1); SBAR(); } while (0)
#ifndef AT_ANTI
#define AT_ANTI 0
#endif
#if AT_ANTI
    if (grp) LDS_BARRIER();
#endif
    for (int kt = 1; kt <= last; ++kt) {
#ifdef PRB_ATTBAR
        const unsigned long long tb0_ = wall_clock64();
#endif
        LDS_BARRIER();
#ifdef PRB_ATTBAR
        if (lane == 0) (void)__hip_atomic_fetch_add((LAS unsigned*)(lds + MISC_OFF + 40), (unsigned)(wall_clock64() - tb0_), __ATOMIC_RELAXED, __HIP_MEMORY_SCOPE_WORKGROUP);
#endif
        if (kt < last) AT_STORE(bo ^ AT_BUF);
        const bool cur = kt <= tmax;
        bf16x8 ka0, ka1, ka2, ka3;
        if (cur) { ka0 = KRD(0, 0); ka1 = KRD(1, 0); }
        SBAR();
#ifdef PRB_LDS
        { bf16x8 d0_ = KRD(0, 1), d1_ = KRD(1, 1), d2_ = KRD(2, 1), d3_ = KRD(3, 1), d4_ = KRD(4, 1), d5_ = KRD(5, 1); PIN(d0_); PIN(d1_); PIN(d2_); PIN(d3_); PIN(d4_); PIN(d5_); SBAR(); }
#endif
        if (prev) AT_S4();
        prev = cur;
        if (kt + 1 < last) AT_LOAD(kt + 2);
        if (cur) {
            const bool dg = (kt == 1 || 64 * kt + 63 > R0);
            f32x16 pA0, pB0, pA1; bf16x8 kq0, kq1, kq2, kq3, kq4, kq5;
            ka2 = KRD(2, 0); ka3 = KRD(3, 0);
            pA0 = MF(ka0, qfA[0], Z16); pB0 = MF(ka0, qfB[0], Z16); ka0 = KRD(4, 0);
            pA0 = MF(ka1, qfA[1], pA0); pB0 = MF(ka1, qfB[1], pB0); ka1 = KRD(5, 0);
            pA0 = MF(ka2, qfA[2], pA0); pB0 = MF(ka2, qfB[2], pB0); kq0 = KRD(0, 1);
            pA0 = MF(ka3, qfA[3], pA0); pB0 = MF(ka3, qfB[3], pB0); kq1 = KRD(1, 1);
            pA0 = MF(ka0, qfA[4], pA0); pB0 = MF(ka0, qfB[4], pB0); kq2 = KRD(2, 1);
            pA0 = MF(ka1, qfA[5], pA0); pB0 = MF(ka1, qfB[5], pB0); kq3 = KRD(3, 1);
            SBAR();
#if AT_ANTI
            LDS_BARRIER();
#endif
            if (dg) { MASKH(pA0, pqA, 0); MASKH(pB0, pqB, 0); }
            float tA, tB, sa = 0.f, sb = 0.f;
            v4u wA0, wA1, wB0, wB1; bf16x8 vf0, vf1, vf2, vf3;
            pA1 = MF(kq0, qfA[0], Z16); tA = RMAX16(pA0); PIN(tA); SBAR();
            pB1 = MF(kq0, qfB[0], Z16); tB = RMAX16(pB0); PIN(tB); SBAR();
            pA1 = MF(kq1, qfA[1], pA1); tA = XMAX(tA); tB = XMAX(tB); kq4 = KRD(4, 1); PIN(tA); PIN(tB); SBAR();
            pB1 = MF(kq1, qfB[1], pB1); kq5 = KRD(5, 1);
            if (__builtin_amdgcn_ballot_w64((tA > mA + AT_THR) || (tB > mB + AT_THR)) != 0ull) {
                const float nA = __builtin_fmaxf(mA, tA), aA = __builtin_amdgcn_exp2f(mA - nA), nB = __builtin_fmaxf(mB, tB), aB = __builtin_amdgcn_exp2f(mB - nB);
                mA = nA; mB = nB; lA *= aA; lB *= aB;
#pragma unroll
                for (int i = 0; i < 16; ++i) { oA0[i] *= aA; oA1[i] *= aA; oB0[i] *= aB; oB1[i] *= aB; } }
            SBAR();
            pA1 = MF(kq2, qfA[2], pA1); EX4(pA0, 0, mA, sa, sb, wA0.x, wA0.y); SBAR();
            pB1 = MF(kq2, qfB[2], pB1); EX4(pA0, 4, mA, sa, sb, wA0.z, wA0.w); PIN(wA0); SBAR();
            pA1 = MF(kq3, qfA[3], pA1); EX4(pA0, 8, mA, sa, sb, wA1.x, wA1.y); SBAR();
            pB1 = MF(kq3, qfB[3], pB1); EX4(pA0, 12, mA, sa, sb, wA1.z, wA1.w); PIN(wA1); lA += sa + sb; sa = 0.f; sb = 0.f; PIN(lA); SBAR();
            pA1 = MF(kq4, qfA[4], pA1); EX4(pB0, 0, mB, sa, sb, wB0.x, wB0.y); SBAR();
            pB1 = MF(kq4, qfB[4], pB1); EX4(pB0, 4, mB, sa, sb, wB0.z, wB0.w); PIN(wB0); SBAR();
            pA1 = MF(kq5, qfA[5], pA1); EX4(pB0, 8, mB, sa, sb, wB1.x, wB1.y); SBAR();
            pB1 = MF(kq5, qfB[5], pB1); EX4(pB0, 12, mB, sa, sb, wB1.z, wB1.w); PIN(wB1); vf0 = VRD(0, 0); lB += sa + sb; PIN(lB); SBAR();
            if (dg) { MASKH(pA1, pqA, 32); MASKH(pB1, pqB, 32); }
            sa = 0.f; sb = 0.f;
            float aA1 = 1.f, aB1 = 1.f; bool rs1;
            oA0 = MF(vf0, BF8(wA0), oA0); tA = RMAX16(pA1); vf1 = VRD(0, 1); PIN(tA); SBAR();
            oB0 = MF(vf0, BF8(wB0), oB0); tB = RMAX16(pB1); vf2 = VRD(1, 0); PIN(tB); SBAR();
            oA1 = MF(vf1, BF8(wA0), oA1); tA = XMAX(tA); tB = XMAX(tB); vf3 = VRD(1, 1); vf4 = VRD(2, 0); PIN(tA); PIN(tB); SBAR();
            oB1 = MF(vf1, BF8(wB0), oB1); vf5 = VRD(2, 1);
            rs1 = __builtin_amdgcn_ballot_w64((tA > mA + AT_THR) || (tB > mB + AT_THR)) != 0ull;
            if (rs1) { const float nA = __builtin_fmaxf(mA, tA), nB = __builtin_fmaxf(mB, tB); aA1 = __builtin_amdgcn_exp2f(mA - nA); aB1 = __builtin_amdgcn_exp2f(mB - nB); mA = nA; mB = nB; lA *= aA1; lB *= aB1; }
            SBAR();
#ifdef PRB_MFMA
            pA0 = MF(vf2, BF8(wA1), pA0); PIN(pA0); SBAR(); pA0 = MF(vf2, BF8(wB1), pA0); PIN(pA0); SBAR(); pA0 = MF(vf3, BF8(wA1), pA0); PIN(pA0); SBAR(); pA0 = MF(vf3, BF8(wB1), pA0); PIN(pA0); SBAR();
#endif
            oA0 = MF(vf2, BF8(wA1), oA0); EX4(pA1, 0, mA, sa, sb, wA2.x, wA2.y); vf6 = VRD(3, 0); SBAR();
            oB0 = MF(vf2, BF8(wB1), oB0); EX4(pA1, 4, mA, sa, sb, wA2.z, wA2.w); PIN(wA2); vf7 = VRD(3, 1); SBAR();
            oA1 = MF(vf3, BF8(wA1), oA1); EX4(pA1, 8, mA, sa, sb, wA3.x, wA3.y); SBAR();
            oB1 = MF(vf3, BF8(wB1), oB1); EX4(pA1, 12, mA, sa, sb, wA3.z, wA3.w); PIN(wA3); lA += sa + sb; sa = 0.f; sb = 0.f; PIN(lA); SBAR();
            if (rs1) {
#pragma unroll
                for (int i = 0; i < 16; ++i) { oA0[i] *= aA1; oA1[i] *= aA1; oB0[i] *= aB1; oB1[i] *= aB1; } }
        }
#if AT_ANTI
        else LDS_BARRIER();
#endif
        bo ^= AT_BUF;
    }
    if (prev) AT_S4();
#undef AT_S4
    TU(3, lds);
#if AT_ANTI
    if (!grp) LDS_BARRIER();
#endif
#undef SBAR
#undef PIN
#undef MF
#undef MX3
#undef RMAX16
#undef XMAX
#undef KRD
#undef VRD
#undef MASKH
#undef EX4
#undef BF8
#undef AT_STORE
#undef AT_LOAD
    const int ln2 = (int)__builtin_amdgcn_mbcnt_hi(~0u, __builtin_amdgcn_mbcnt_lo(~0u, 0u)), hh2 = ln2 >> 5, pqA2 = R0 + (ln2 & 31), pqB2 = pqA2 + 32;
    { const auto ra_ = __builtin_amdgcn_permlane32_swap(__float_as_uint(lA), __float_as_uint(lA), false, false); lA = __uint_as_float(ra_[0]) + __uint_as_float(ra_[1]);
      const auto rb_ = __builtin_amdgcn_permlane32_swap(__float_as_uint(lB), __float_as_uint(lB), false, false); lB = __uint_as_float(rb_[0]) + __uint_as_float(rb_[1]); }
    const float iA = lA > 0.f ? 1.f / lA : 0.f, iB = lB > 0.f ? 1.f / lB : 0.f;
#define AT_OUT(O0, O1, INV, PQ) do { \
        const v4u q0 = pack_rowpair(O0[0] * INV, O0[1] * INV, O0[2] * INV, O0[3] * INV, O0[4] * INV, O0[5] * INV, O0[6] * INV, O0[7] * INV); \
        const v4u q1 = pack_rowpair(O0[8] * INV, O0[9] * INV, O0[10] * INV, O0[11] * INV, O0[12] * INV, O0[13] * INV, O0[14] * INV, O0[15] * INV); \
        const v4u q2 = pack_rowpair(O1[0] * INV, O1[1] * INV, O1[2] * INV, O1[3] * INV, O1[4] * INV, O1[5] * INV, O1[6] * INV, O1[7] * INV); \
        const v4u q3 = pack_rowpair(O1[8] * INV, O1[9] * INV, O1[10] * INV, O1[11] * INV, O1[12] * INV, O1[13] * INV, O1[14] * INV, O1[15] * INV); \
        if (PQ >= 0) { GAS v4u* op = (GAS v4u*)(Oout + (size_t)((unsigned)(rowb + PQ) & omask) * 1024 + h * 64 + 8 * hh2); op[0] = q0; op[2] = q1; op[4] = q2; op[6] = q3; } } while (0)
    AT_OUT(oA0, oA1, iA, pqA2);
    AT_OUT(oB0, oB1, iB, pqB2);
#undef AT_OUT
    TU(4, lds);
}

constexpr int SD_P = 144, SD_IMG = 128 * SD_P, SD_B = 0, SD_C = SD_IMG, SD_HD = 2 * SD_IMG, SD_HSZ = 2 * SD_IMG + 64 * SD_P + 2048;
constexpr int SD_XDT = 0, SD_XDD = SD_IMG, SD_S = 2 * SD_IMG, SD_SC = 2 * SD_IMG + 64 * SD_P;
static_assert(SD_HD + 2 * SD_HSZ <= RING_BYTES, "SSD LDS map");
__device__ __forceinline__ bf16x8 ssd_tr8(const LAS unsigned char* p) {
    const v4i16_t lo = __builtin_amdgcn_ds_read_tr16_b64_v4i16((LAS v4i16_t*)p), hi = __builtin_amdgcn_ds_read_tr16_b64_v4i16((LAS v4i16_t*)(p + 8 * SD_P));
    return (bf16x8){lo[0], lo[1], lo[2], lo[3], hi[0], hi[1], hi[2], hi[3]};
}
__device__ __forceinline__ void ssd_unit(int b, int hp, const In& I, const bf16* XBC, const float* DT, bf16* Y, LAS unsigned char* lds, int tid) {
    const int lane = tid & 63, wave = __builtin_amdgcn_readfirstlane(tid >> 6), r = lane & 31, hh = lane >> 5;
    const int hs = wave >> 2, lb = hs ? 3 - (wave & 3) : (wave & 3), h = 2 * hp + hs, g = hp >> 2;
    const float Ah = -__expf(I.a_log[h]), Dh = I.d_skip[h];
    LAS unsigned char* HD = lds + SD_HD + hs * SD_HSZ;
    LAS float* SC = (LAS float*)(HD + SD_SC);
    const size_t rowb = (size_t)b * LP;
    const int cg = tid & 31, rg = tid >> 5;
    const int gcol = cg < 16 ? (2 * hp) * 64 + cg * 8 : (cg < 24 ? 1024 + g * 64 + (cg - 16) * 8 : 1152 + g * 64 + (cg - 24) * 8);
    float cw[4][8], cbias[8];
#pragma unroll
    for (int k = 0; k < 8; ++k) { cbias[k] = I.conv_b[gcol + k];
#pragma unroll
        for (int t = 0; t < 4; ++t) cw[t][k] = I.conv_w[t * CONVD + gcol + k]; }
    const GAS bf16* graw = (const GAS bf16*)(XBC + (rowb + 8 * rg - 3) * CONVD + gcol);
    LAS unsigned char* wdst = lds + (cg < 16 ? SD_HD + (cg >> 3) * SD_HSZ + SD_XDT : (cg < 24 ? SD_B : SD_C)) + (8 * rg) * SD_P + (cg & 7) * 16;
    LAS float* WSC = (LAS float*)(lds + SD_HD + ((cg >> 3) & 1) * SD_HSZ + SD_SC);
    v4u raw[11];
#define SD_LOAD(c) do { _Pragma("unroll") for (int i = 0; i < 11; ++i) raw[i] = *(const GAS v4u*)(graw + ((size_t)(c) * 128 + i) * CONVD); } while (0)
    SD_LOAD(0);
    f32x16 Sreg;
#pragma unroll
    for (int i = 0; i < 16; ++i) Sreg[i] = 0.f;
    const int l = 32 * lb + r, pt = lb & 1, nt = lb >> 1;
    const int q4 = (lane & 15) >> 2, pp = lane & 3, gg = (lane >> 4) & 1;
    const int troff = (4 * hh + q4) * SD_P + (16 * gg + 4 * pp) * 2;
    float dn0 = 0.f, dn1 = 0.f;
    const GAS float* DTg = (const GAS float*)DT;
    if (lb == 3) { const int l0 = 2 * lane; dn0 = (l0 >= PADF) ? DTg[(rowb + l0) * 16 + h] : 0.f; dn1 = (l0 + 1 >= PADF) ? DTg[(rowb + l0 + 1) * 16 + h] : 0.f; }
#ifdef PRB_SSEG
    unsigned sp_ = 0, sacc_ = 0;
#define STNOW() ((unsigned)__builtin_amdgcn_readfirstlane((int)(unsigned)wall_clock64()))
#define TS(k) do { if ((k) == PRB_SSEG) sp_ = STNOW(); if ((k) == PRB_SSEG2) sacc_ += STNOW() - sp_; } while (0)
#else
#define TS(k) do { } while (0)
#endif
    for (int c = 0; c < NCHUNK; ++c) {
        TS(0);
        LDS_BARRIER();
        TS(1);
        if (lb == 3) {
            const int l0 = 2 * lane; const float d0 = dn0, d1 = dn1;
            if (c + 1 < NCHUNK) { const size_t rr = rowb + (size_t)(c + 1) * 128 + l0; dn0 = DTg[rr * 16 + h]; dn1 = DTg[(rr + 1) * 16 + h]; }
            const float a0 = d0 * Ah, a1 = d1 * Ah; float v = a0 + a1;
#pragma unroll
            for (int o = 1; o < 64; o <<= 1) { const float t = __shfl_up(v, o); if (lane >= o) v += t; }
            const float tot = __shfl(v, 63), acs1 = v, acs0 = v - a1;
            SC[l0] = d0 > 0.f ? acs0 - __logf(d0) : 1e30f; SC[l0 + 1] = d1 > 0.f ? acs1 - __logf(d1) : 1e30f; SC[128 + l0] = acs0; SC[129 + l0] = acs1; SC[256 + l0] = __expf(acs0); SC[257 + l0] = __expf(acs1); SC[384 + l0] = d0 * __expf(tot - acs0); SC[385 + l0] = d1 * __expf(tot - acs1);
        }
        {
#pragma unroll
            for (int i = 0; i < 16; ++i) *(LAS bf16*)(HD + SD_S + (32 * pt + (i & 3) + 8 * (i >> 2) + 4 * hh) * SD_P + (32 * nt + r) * 2) = (bf16)f2bf(Sreg[i]);
        }
        v4u xkeep[8];
        {
#pragma unroll
            for (int j = 0; j < 8; ++j) { const int ll = 8 * rg + j; const bool real = c > 0 || ll >= PADF; float v[8];
#pragma unroll
                for (int k = 0; k < 8; ++k) { float a = cbias[k];
#pragma unroll
                    for (int t = 0; t < 4; ++t) { const unsigned w = raw[j + t][k >> 1]; a += cw[t][k] * ((k & 1) ? bfhi(w) : bflo(w)); }
                    v[k] = real ? silu(a) : 0.f; }
                xkeep[j] = (v4u){cvtpk(v[0], v[1]), cvtpk(v[2], v[3]), cvtpk(v[4], v[5]), cvtpk(v[6], v[7])};
                *(LAS v4u*)(wdst + j * SD_P) = xkeep[j]; }
        }
        TS(2);
        LDS_BARRIER();
        TS(3);
        if (cg < 16) {
#pragma unroll
            for (int j = 0; j < 8; ++j) { const int ll = 8 * rg + j; LAS unsigned char* d = wdst + j * SD_P; const v4u xw = xkeep[j]; const float dd = WSC[384 + ll];
                *(LAS v4u*)(d + SD_XDD) = (v4u){cvtpk(bflo(xw.x) * dd, bfhi(xw.x) * dd), cvtpk(bflo(xw.y) * dd, bfhi(xw.y) * dd), cvtpk(bflo(xw.z) * dd, bfhi(xw.z) * dd), cvtpk(bflo(xw.w) * dd, bfhi(xw.w) * dd)}; }
        }
        TS(4);
        LDS_BARRIER();
        TS(5);
        if (c + 1 < NCHUNK) SD_LOAD(c + 1);
        bf16x8 cf[4];
#pragma unroll
        for (int ks = 0; ks < 4; ++ks) cf[ks] = *(const LAS bf16x8*)(lds + SD_C + l * SD_P + (16 * ks + 8 * hh) * 2);
        f32x16 acc0, acc1;
#pragma unroll
        for (int i = 0; i < 16; ++i) { acc0[i] = 0.f; acc1[i] = 0.f; }
#pragma unroll
        for (int ks = 0; ks < 4; ++ks) { const LAS unsigned char* sp = HD + SD_S + r * SD_P + (16 * ks + 8 * hh) * 2;
            acc0 = __builtin_amdgcn_mfma_f32_32x32x16_bf16(*(const LAS bf16x8*)sp, cf[ks], acc0, 0, 0, 0); acc1 = __builtin_amdgcn_mfma_f32_32x32x16_bf16(*(const LAS bf16x8*)(sp + 32 * SD_P), cf[ks], acc1, 0, 0, 0); }
        { const float ea = SC[256 + l];
#pragma unroll
          for (int i = 0; i < 16; ++i) { acc0[i] *= ea; acc1[i] *= ea; } }
        const float acl = SC[128 + l];
#pragma unroll 1
        for (int sb = 0; sb <= lb; ++sb) {
            bf16x8 bq[4], tq[4]; f32x4 asq[4];
            const LAS unsigned char* vp = HD + SD_XDT + (32 * sb) * SD_P + troff;
#pragma unroll
            for (int ks = 0; ks < 4; ++ks) bq[ks] = *(const LAS bf16x8*)(lds + SD_B + (32 * sb + r) * SD_P + (16 * ks + 8 * hh) * 2);
#pragma unroll
            for (int g4 = 0; g4 < 4; ++g4) asq[g4] = *(const LAS f32x4*)(SC + 32 * sb + 8 * g4 + 4 * hh);
            __builtin_amdgcn_sched_barrier(0);
            f32x16 X;
#pragma unroll
            for (int i = 0; i < 16; ++i) X[i] = 0.f;
#pragma unroll
            for (int ks = 0; ks < 4; ++ks) X = __builtin_amdgcn_mfma_f32_32x32x16_bf16(bq[ks], cf[ks], X, 0, 0, 0);
            tq[0] = ssd_tr8(vp); tq[1] = ssd_tr8(vp + 64); tq[2] = ssd_tr8(vp + 16 * SD_P); tq[3] = ssd_tr8(vp + 16 * SD_P + 64);
            __builtin_amdgcn_sched_barrier(0);
#pragma unroll
            for (int g4 = 0; g4 < 4; ++g4) { const int s0 = 32 * sb + 8 * g4 + 4 * hh;
#pragma unroll
                for (int j = 0; j < 4; ++j) { const float f = (s0 + j <= l) ? __expf(acl - asq[g4][j]) : 0.f; X[4 * g4 + j] *= f; } }
            v4u w0, w1;
            w0.x = cvtpk(X[0], X[1]); w0.y = cvtpk(X[2], X[3]); w0.z = cvtpk(X[4], X[5]); w0.w = cvtpk(X[6], X[7]);
            w1.x = cvtpk(X[8], X[9]); w1.y = cvtpk(X[10], X[11]); w1.z = cvtpk(X[12], X[13]); w1.w = cvtpk(X[14], X[15]);
            acc0 = __builtin_amdgcn_mfma_f32_32x32x16_bf16(tq[0], __builtin_bit_cast(bf16x8, w0), acc0, 0, 0, 0);
            acc1 = __builtin_amdgcn_mfma_f32_32x32x16_bf16(tq[1], __builtin_bit_cast(bf16x8, w0), acc1, 0, 0, 0);
            acc0 = __builtin_amdgcn_mfma_f32_32x32x16_bf16(tq[2], __builtin_bit_cast(bf16x8, w1), acc0, 0, 0, 0);
            acc1 = __builtin_amdgcn_mfma_f32_32x32x16_bf16(tq[3], __builtin_bit_cast(bf16x8, w1), acc1, 0, 0, 0);
        }
        { const float rdt = Dh;
          GAS v4u* yp = (GAS v4u*)(Y + (rowb + (size_t)c * 128 + l) * 1024 + h * 64 + 8 * hh); const LAS unsigned char* xp = HD + SD_XDT + l * SD_P + (4 * hh) * 2;
#pragma unroll
          for (int m = 0; m < 2; ++m) { const u32x2 xa = *(const LAS u32x2*)(xp + 32 * m), xc = *(const LAS u32x2*)(xp + 32 * m + 16), xb = *(const LAS u32x2*)(xp + 64 + 32 * m), xd = *(const LAS u32x2*)(xp + 64 + 32 * m + 16);
              yp[2 * m] = pack_rowpair(acc0[8 * m] + rdt * bflo(xa.x), acc0[8 * m + 1] + rdt * bfhi(xa.x), acc0[8 * m + 2] + rdt * bflo(xa.y), acc0[8 * m + 3] + rdt * bfhi(xa.y),
                                       acc0[8 * m + 4] + rdt * bflo(xc.x), acc0[8 * m + 5] + rdt * bfhi(xc.x), acc0[8 * m + 6] + rdt * bflo(xc.y), acc0[8 * m + 7] + rdt * bfhi(xc.y));
              yp[4 + 2 * m] = pack_rowpair(acc1[8 * m] + rdt * bflo(xb.x), acc1[8 * m + 1] + rdt * bfhi(xb.x), acc1[8 * m + 2] + rdt * bflo(xb.y), acc1[8 * m + 3] + rdt * bfhi(xb.y),
                                           acc1[8 * m + 4] + rdt * bflo(xd.x), acc1[8 * m + 5] + rdt * bfhi(xd.x), acc1[8 * m + 6] + rdt * bflo(xd.y), acc1[8 * m + 7] + rdt * bfhi(xd.y)); } }
        TS(6);
        { const float cd = SC[256 + 127];
#pragma unroll
          for (int i = 0; i < 16; ++i) Sreg[i] *= cd;
#pragma unroll
          for (int ks = 0; ks < 8; ++ks) { const bf16x8 a = ssd_tr8(HD + SD_XDD + (16 * ks) * SD_P + (32 * pt) * 2 + troff), bb = ssd_tr8(lds + SD_B + (16 * ks) * SD_P + (32 * nt) * 2 + troff);
              Sreg = __builtin_amdgcn_mfma_f32_32x32x16_bf16(a, bb, Sreg, 0, 0, 0); } }
        TS(7);
    }
#ifdef PRB_SSEG
    if (lane == 0) (void)__hip_atomic_fetch_add((LAS unsigned*)(lds + MISC_OFF + 40), sacc_, __ATOMIC_RELAXED, __HIP_MEMORY_SCOPE_WORKGROUP);
#endif
#undef SD_LOAD
    __syncthreads();
}


__device__ __forceinline__ void p5_groupnorm(bf16* Y, const bf16* Z, int gw, int NGW, int lane) {
#define GN_ADDR(T, P, ZQ) do { const int t_ = (T) < NB * SEQ ? (T) : gw; const int row_ = (t_ >> 12) * LP + PADF + NMETA + (t_ & 4095); P = (v4u*)(Y + (size_t)row_ * 1024) + 2 * lane; ZQ = (const v4u*)(Z + (size_t)row_ * 1024) + 2 * lane; } while (0)
#define GN_ROW(A, C, ZA, ZC, P) do { float f[16]; \
        f[0] = bflo(A.x); f[1] = bfhi(A.x); f[2] = bflo(A.y); f[3] = bfhi(A.y); f[4] = bflo(A.z); f[5] = bfhi(A.z); f[6] = bflo(A.w); f[7] = bfhi(A.w); \
        f[8] = bflo(C.x); f[9] = bfhi(C.x); f[10] = bflo(C.y); f[11] = bfhi(C.y); f[12] = bflo(C.z); f[13] = bfhi(C.z); f[14] = bflo(C.w); f[15] = bfhi(C.w); \
        f[0] *= bflo(ZA.x); f[1] *= bfhi(ZA.x); f[2] *= bflo(ZA.y); f[3] *= bfhi(ZA.y); f[4] *= bflo(ZA.z); f[5] *= bfhi(ZA.z); f[6] *= bflo(ZA.w); f[7] *= bfhi(ZA.w); \
        f[8] *= bflo(ZC.x); f[9] *= bfhi(ZC.x); f[10] *= bflo(ZC.y); f[11] *= bfhi(ZC.y); f[12] *= bflo(ZC.z); f[13] *= bfhi(ZC.z); f[14] *= bflo(ZC.w); f[15] *= bfhi(ZC.w); \
        float s = 0.f; _Pragma("unroll") for (int i = 0; i < 16; ++i) s += f[i] * f[i]; \
        _Pragma("unroll") for (int o = 1; o < 32; o <<= 1) s += __shfl_xor(s, o); \
        const float rs = rsqrtf(s * (1.f / 512.f) + EPS); \
        P[0] = (v4u){cvtpk(f[0] * rs, f[1] * rs), cvtpk(f[2] * rs, f[3] * rs), cvtpk(f[4] * rs, f[5] * rs), cvtpk(f[6] * rs, f[7] * rs)}; \
        P[1] = (v4u){cvtpk(f[8] * rs, f[9] * rs), cvtpk(f[10] * rs, f[11] * rs), cvtpk(f[12] * rs, f[13] * rs), cvtpk(f[14] * rs, f[15] * rs)}; } while (0)
    v4u *p, *p2; const v4u *zq, *zq2;
    GN_ADDR(gw, p, zq); GN_ADDR(gw + NGW, p2, zq2);
#define NTL(q_) __builtin_nontemporal_load(q_)
    v4u a = NTL(p), c = NTL(p + 1), a2 = NTL(p2), c2 = NTL(p2 + 1), za = zq[0], zc = zq[1], za2 = zq2[0], zc2 = zq2[1];
    for (int t = gw; t < NB * SEQ; t += 2 * NGW) {
        v4u *np, *np2; const v4u *nzq, *nzq2;
        GN_ADDR(t + 2 * NGW, np, nzq); GN_ADDR(t + 3 * NGW, np2, nzq2);
        const v4u na = NTL(np), nc = NTL(np + 1), na2 = NTL(np2), nc2 = NTL(np2 + 1), nza = nzq[0], nzc = nzq[1], nza2 = nzq2[0], nzc2 = nzq2[1];
        GN_ROW(a, c, za, zc, p);
        if (t + NGW < NB * SEQ) GN_ROW(a2, c2, za2, zc2, p2);
        a = na; c = nc; a2 = na2; c2 = nc2; za = nza; zc = nzc; za2 = nza2; zc2 = nzc2; p = np; p2 = np2;
    }
#undef GN_ROW
#undef GN_ADDR
#undef NTL
}

__device__ __forceinline__ void p2_rowpass(const float* KRF, bf16* KR, float* DT, const float* CS, const float* dt_bias, int gtid, int nthr) {
    constexpr int NT = 5;
    for (int base = gtid; base < MROWS * 16; base += NT * nthr) {
        float x1[NT], x2[NT], c[NT], sn[NT], xd[NT]; int tk[NT];
#pragma unroll
        for (int i = 0; i < NT; ++i) { const int idx = base + i * nthr; tk[i] = -1; x1[i] = x2[i] = c[i] = sn[i] = xd[i] = 0.f;
            if (idx < MROWS * 16) { const int row = idx >> 4, j = idx & 15; int b; const int tok = row_tok(row, b); tk[i] = tok;
                if (tok >= 0) { x1[i] = KRF[(size_t)row * 32 + j]; x2[i] = KRF[(size_t)row * 32 + 16 + j]; c[i] = CS[(size_t)tok * 32 + j]; sn[i] = CS[(size_t)tok * 32 + 16 + j]; xd[i] = DT[idx]; } } }
#pragma unroll
        for (int i = 0; i < NT; ++i) { const int idx = base + i * nthr;
            if (idx < MROWS * 16) { const int row = idx >> 4, j = idx & 15; float o1 = 0.f, o2 = 0.f, d = 0.f;
                if (tk[i] >= 0) { o1 = x1[i] * c[i] - x2[i] * sn[i]; o2 = x2[i] * c[i] + x1[i] * sn[i]; const float x = xd[i] + dt_bias[j]; d = fmaxf(x, 0.f) + __logf(1.f + __expf(-fabsf(x))); }
                KR[(size_t)row * 32 + j] = (bf16)f2bf(o1); KR[(size_t)row * 32 + 16 + j] = (bf16)f2bf(o2); DT[idx] = d; } }
    }
}
constexpr int WE_P = 1028;
__device__ __forceinline__ void p10_router(const In& I, unsigned char* ws, float* WE, LAS unsigned* lcnt, int bx, int gw, int NGW, int tid, int lane) {
    { f32x4 wv[16];
#pragma unroll
      for (int i = 0; i < 16; ++i) wv[i] = ((const GAS f32x4*)I.w_expert)[tid + 512 * i];
#pragma unroll
      for (int i = 0; i < 16; ++i) { const int e = 4 * (tid + 512 * i), k = e >> 5, c = e & 31; WE[c * WE_P + k] = wv[i][0]; WE[(c + 1) * WE_P + k] = wv[i][1]; WE[(c + 2) * WE_P + k] = wv[i][2]; WE[(c + 3) * WE_P + k] = wv[i][3]; } }
    if (tid < 32) lcnt[tid] = 0u;
    __syncthreads();
    const GAS bf16* DL = (const GAS bf16*)(ws + WS_DL); GAS bf16* VN = (GAS bf16*)(ws + WS_XN); GAS float* TOKW = (GAS float*)(ws + WS_TOKW); GAS int* TOKE = (GAS int*)(ws + WS_TOKE); GAS int* HIST = (GAS int*)(ws + WS_HIST);
    f32x4 nf[4]; f32x4 wgv[16];
#pragma unroll
    for (int q = 0; q < 4; ++q) { nf[q] = *(const GAS f32x4*)(I.norm_ffn + 4 * lane + 256 * q);
#pragma unroll
        for (int i = 0; i < 4; ++i) wgv[4 * q + i] = *(const GAS f32x4*)(I.w_group + 4 * (4 * lane + 256 * q + i)); }
    f32x4 hn[4], hm[4];
#define RT_LOAD(H, t_) do { const int rr_ = ((t_) >> 12) * LP + PADF + NMETA + ((t_) & 4095); const GAS float* xp = (const GAS float*)(I.x + (size_t)(t_) * 1024 + 4 * lane); const GAS bf16* dp = DL + (size_t)rr_ * 1024 + 4 * lane; \
        _Pragma("unroll") for (int q = 0; q < 4; ++q) { const u32x2 dw = __builtin_nontemporal_load((const GAS u32x2*)(dp + 256 * q)); H[q] = __builtin_nontemporal_load((const GAS f32x4*)(xp + 256 * q)) + (f32x4){bflo(dw.x), bfhi(dw.x), bflo(dw.y), bfhi(dw.y)}; } } while (0)
    auto route = [&](const f32x4 (&hin)[4], int row, bool st, int& e0_o, int& e1_o, float& w0_o, float& w1_o) {
            f32x4 v[4]; float s = 0.f;
    #pragma unroll
            for (int q = 0; q < 4; ++q) { v[q] = hin[q]; s += (v[q][0] * v[q][0] + v[q][1] * v[q][1]) + (v[q][2] * v[q][2] + v[q][3] * v[q][3]); }
            const float rs = rsqrtf(wave_sum(s) * (1.f / DM) + EPS);
            float gl[4] = {0.f, 0.f, 0.f, 0.f};
    #pragma unroll
            for (int q = 0; q < 4; ++q) { v[q] = v[q] * rs * nf[q];
                if (st) *(GAS u32x2*)(VN + (size_t)row * 1024 + 4 * lane + 256 * q) = (u32x2){cvtpk(v[q][0], v[q][1]), cvtpk(v[q][2], v[q][3])};
    #pragma unroll
                for (int i = 0; i < 4; ++i) { const f32x4 wg = wgv[4 * q + i]; gl[0] += v[q][i] * wg[0]; gl[1] += v[q][i] * wg[1]; gl[2] += v[q][i] * wg[2]; gl[3] += v[q][i] * wg[3]; } }
            {
              const int hi = lane >> 5, b4 = (lane >> 4) & 1;
              const float s0 = hi ? gl[0] : gl[2], s1 = hi ? gl[1] : gl[3];
              const float k0 = (hi ? gl[2] : gl[0]) + __shfl_xor(s0, 32), k1 = (hi ? gl[3] : gl[1]) + __shfl_xor(s1, 32);
              float k = (b4 ? k1 : k0) + __shfl_xor(b4 ? k0 : k1, 16);
              k += __shfl_xor(k, 8); k += __shfl_xor(k, 4); k += __shfl_xor(k, 2); k += __shfl_xor(k, 1);
    #pragma unroll
              for (int i = 0; i < 4; ++i) gl[i] = __int_as_float(__builtin_amdgcn_readlane(__float_as_int(k), 32 * (i >> 1) + 16 * (i & 1))) + I.b_group[i]; }
            int g = 0; float gm = gl[0];
    #pragma unroll
            for (int i = 1; i < 4; ++i) if (gl[i] > gm) { gm = gl[i]; g = i; }
            float den = 0.f;
    #pragma unroll
            for (int i = 0; i < 4; ++i) den += __expf(gl[i] - gm);
            const float pg = 1.f / den;
            float el[8];
    #pragma unroll
            for (int i = 0; i < 8; ++i) { const float* wp = WE + (8 * g + i) * WE_P + 4 * lane; float a = 0.f;
    #pragma unroll
                for (int q = 0; q < 4; ++q) { const f32x4 w4 = *(const f32x4*)(wp + 256 * q); a += (v[q][0] * w4[0] + v[q][1] * w4[1]) + (v[q][2] * w4[2] + v[q][3] * w4[3]); }
                el[i] = a; }
            {
              const int hi = lane >> 5, b4 = (lane >> 4) & 1, b3 = (lane >> 3) & 1; float k4[4], k2[2];
    #pragma unroll
              for (int i = 0; i < 4; ++i) k4[i] = (hi ? el[4 + i] : el[i]) + __shfl_xor(hi ? el[i] : el[4 + i], 32);
    #pragma unroll
              for (int i = 0; i < 2; ++i) k2[i] = (b4 ? k4[2 + i] : k4[i]) + __shfl_xor(b4 ? k4[i] : k4[2 + i], 16);
              float k = (b3 ? k2[1] : k2[0]) + __shfl_xor(b3 ? k2[0] : k2[1], 8);
              k += __shfl_xor(k, 4); k += __shfl_xor(k, 2); k += __shfl_xor(k, 1);
    #pragma unroll
              for (int i = 0; i < 8; ++i) el[i] = __int_as_float(__builtin_amdgcn_readlane(__float_as_int(k), 32 * (i >> 2) + 16 * ((i >> 1) & 1) + 8 * (i & 1))) + I.b_expert[8 * g + i]; }
            int i0 = 0; float v0 = el[0];
    #pragma unroll
            for (int i = 1; i < 8; ++i) if (el[i] > v0) { v0 = el[i]; i0 = i; }
            int i1 = -1; float v1 = -3.0e38f;
    #pragma unroll
            for (int i = 0; i < 8; ++i) if (i != i0 && el[i] > v1) { v1 = el[i]; i1 = i; }
            if (i1 < 0) i1 = i0 == 0 ? 1 : 0;
            const float w0 = 1.f / (1.f + __expf(v1 - v0)), w1 = 1.f - w0;
        e0_o = 8 * g + i0; e1_o = 8 * g + i1; w0_o = w0 * pg; w1_o = w1 * pg;
    };
    if (gw < NB * SEQ) RT_LOAD(hn, gw);
    if (gw + NGW < NB * SEQ) RT_LOAD(hm, gw + NGW);
    for (int t = gw; t < NB * SEQ; t += 2 * NGW) { const int t2 = t + NGW; const bool has2 = t2 < NB * SEQ; const int tb = has2 ? t2 : t;
        const int rowA = (t >> 12) * LP + PADF + NMETA + (t & 4095), rowB = (tb >> 12) * LP + PADF + NMETA + (tb & 4095);
        f32x4 va[4], vb[4];
#pragma unroll
        for (int q = 0; q < 4; ++q) { va[q] = hn[q]; vb[q] = has2 ? hm[q] : hn[q]; }
        { const int tn = t + 2 * NGW; if (tn < NB * SEQ) RT_LOAD(hn, tn); if (tn + NGW < NB * SEQ) RT_LOAD(hm, tn + NGW); }
        int e0A, e1A, e0B, e1B; float w0A, w1A, w0B, w1B;
        route(va, rowA, true, e0A, e1A, w0A, w1A); route(vb, rowB, has2, e0B, e1B, w0B, w1B);
        if (lane == 0) {
            const unsigned r0 = __hip_atomic_fetch_add(lcnt + e0A, 1u, __ATOMIC_RELAXED, __HIP_MEMORY_SCOPE_WORKGROUP), r1 = __hip_atomic_fetch_add(lcnt + e1A, 1u, __ATOMIC_RELAXED, __HIP_MEMORY_SCOPE_WORKGROUP);
            TOKE[rowA * 2] = e0A | (int)(r0 << 8); TOKE[rowA * 2 + 1] = e1A | (int)(r1 << 8); TOKW[rowA * 2] = w0A; TOKW[rowA * 2 + 1] = w1A;
            if (has2) { const unsigned r2 = __hip_atomic_fetch_add(lcnt + e0B, 1u, __ATOMIC_RELAXED, __HIP_MEMORY_SCOPE_WORKGROUP), r3 = __hip_atomic_fetch_add(lcnt + e1B, 1u, __ATOMIC_RELAXED, __HIP_MEMORY_SCOPE_WORKGROUP);
                TOKE[rowB * 2] = e0B | (int)(r2 << 8); TOKE[rowB * 2 + 1] = e1B | (int)(r3 << 8); TOKW[rowB * 2] = w0B; TOKW[rowB * 2 + 1] = w1B; } }
    }
#undef RT_LOAD
    __syncthreads();
    if (tid < 32) HIST[bx * 32 + tid] = (int)lcnt[tid];
}
__device__ __forceinline__ void moe_ost_scan(int c, volatile LAS int* ost, int tid) {
    const int v = tid < NEXP ? (c + 255) & ~255 : 0; int inc = v;
#pragma unroll
    for (int o = 1; o < NEXP; o <<= 1) { const int t = __shfl_up(inc, o); if ((tid & 63) >= o) inc += t; }
    if (tid < NEXP) ost[tid] = inc - v;
    if (tid == NEXP - 1) ost[NEXP] = inc;
}
__device__ __forceinline__ void moe_bases(unsigned char* ws, volatile LAS int* ost, volatile LAS int* cnt, volatile LAS int* base, volatile LAS int* part, int bx, int G, int tid) {
    const int* HIST = (const int*)(ws + WS_HIST); int* CNTG = (int*)(ws + WS_CNTG);
    __syncthreads();
    { const int e = tid & 31, pi = tid >> 5, per = (G + 15) >> 4, w0 = pi * per; int tot = 0, bs = 0;
#pragma unroll 16
      for (int i = 0; i < per; ++i) { const int w = w0 + i; if (w < G) { const int hc = HIST[w * 32 + e]; tot += hc; bs += (w < bx) ? hc : 0; } }
      part[pi * 32 + e] = tot; part[512 + pi * 32 + e] = bs; }
    __syncthreads();
    if (tid < 32) { int tot = 0, bs = 0;
#pragma unroll
        for (int pi = 0; pi < 16; ++pi) { tot += part[pi * 32 + tid]; bs += part[512 + pi * 32 + tid]; }
        cnt[tid] = tot; base[tid] = bs; if (bx == 0) CNTG[tid] = tot; }
    __syncthreads();
    if (tid < 64) moe_ost_scan(tid < NEXP ? cnt[tid] : 0, ost, tid);
    __syncthreads();
}
__device__ __forceinline__ void moe_offsets(unsigned char* ws, volatile LAS int* ost, volatile LAS int* cnt, int tid) {
    const int* CNTG = (const int*)(ws + WS_CNTG);
    __syncthreads();
    if (tid < 64) { const int c = tid < NEXP ? CNTG[tid] : 0; if (tid < NEXP) cnt[tid] = c; moe_ost_scan(c, ost, tid); }
    __syncthreads();
}
__device__ __forceinline__ void p11_index(unsigned char* ws, volatile LAS int* ost, volatile LAS int* cnt, volatile LAS int* base, int gw, int NGW, int lane) {
    const int* TOKE = (const int*)(ws + WS_TOKE); int* PROW = (int*)(ws + WS_PROW); int* GIDX = (int*)(ws + WS_GIDX);
    for (int t0 = gw; t0 < NB * SEQ; t0 += 32 * NGW) { const int t = t0 + (lane >> 1) * NGW, sl = lane & 1;
        if (t < NB * SEQ) { const int row = (t >> 12) * LP + PADF + NMETA + (t & 4095); const int code = TOKE[row * 2 + sl]; const int e = code & 255, pr = ost[e] + base[e] + (code >> 8); GIDX[pr] = row; PROW[pr] = row * 2 + sl; } }
    if (gw < NEXP) { const int e = gw; const int p0 = ost[e] + cnt[e], np = ost[e + 1] - p0;
        for (int j = lane; j < np; j += 64) { GIDX[p0 + j] = 0; PROW[p0 + j] = -1; } }
}
__device__ __forceinline__ void p13_final(const In& I, unsigned char* ws, float* out, int gw, int NGW, int lane, bool poison) {
    const bf16* DL = (const bf16*)(ws + WS_DL); const bf16* YP = (const bf16*)(ws + WS_YP);
    f32x4 nfv[4];
#pragma unroll
    for (int j = 0; j < 4; ++j) nfv[j] = *(const f32x4*)(I.norm_final + 4 * (lane + 64 * j));
    for (int t = gw; t < NB * SEQ; t += 2 * NGW) {
        const int t2 = t + NGW; const bool has2 = t2 < NB * SEQ; const int tb = has2 ? t2 : t;
        const size_t row = (size_t)(t >> 12) * LP + PADF + NMETA + (t & 4095), row2 = (size_t)(tb >> 12) * LP + PADF + NMETA + (tb & 4095);
        f32x4 h[4], h2[4]; u32x2 ya[4], yb[4], ya2[4], yb2[4], da[4], da2[4];
#pragma unroll
        for (int j = 0; j < 4; ++j) { const int c = 4 * (lane + 64 * j); h[j] = __builtin_nontemporal_load((const f32x4*)(I.x + (size_t)t * 1024 + c)); da[j] = __builtin_nontemporal_load((const u32x2*)(DL + row * 1024 + c)); ya[j] = __builtin_nontemporal_load((const u32x2*)(YP + row * 1024 + c)); yb[j] = __builtin_nontemporal_load((const u32x2*)(YP + ((size_t)MROWS + row) * 1024 + c));
            h2[j] = __builtin_nontemporal_load((const f32x4*)(I.x + (size_t)tb * 1024 + c)); da2[j] = __builtin_nontemporal_load((const u32x2*)(DL + row2 * 1024 + c)); ya2[j] = __builtin_nontemporal_load((const u32x2*)(YP + row2 * 1024 + c)); yb2[j] = __builtin_nontemporal_load((const u32x2*)(YP + ((size_t)MROWS + row2) * 1024 + c)); }
#define FIN_ROW(H, YA, YB, DA, T) do { float s = 0.f; \
        _Pragma("unroll") for (int j = 0; j < 4; ++j) { H[j] += (f32x4){bflo(DA[j].x), bfhi(DA[j].x), bflo(DA[j].y), bfhi(DA[j].y)}; H[j] += (f32x4){bflo(YA[j].x) + bflo(YB[j].x), bfhi(YA[j].x) + bfhi(YB[j].x), bflo(YA[j].y) + bflo(YB[j].y), bfhi(YA[j].y) + bfhi(YB[j].y)}; \
            s += (H[j][0] * H[j][0] + H[j][1] * H[j][1]) + (H[j][2] * H[j][2] + H[j][3] * H[j][3]); } \
        const float rs = rsqrtf(wave_sum(s) * (1.f / DM) + EPS); \
        _Pragma("unroll") for (int j = 0; j < 4; ++j) { f32x4 o = H[j] * rs * nfv[j]; if (poison) { const float q = __builtin_nanf(""); o = (f32x4){q, q, q, q}; } *(f32x4*)(out + (size_t)(T) * DM + 4 * (lane + 64 * j)) = o; } } while (0)
        FIN_ROW(h, ya, yb, da, t);
        if (has2) FIN_ROW(h2, ya2, yb2, da2, t2);
#undef FIN_ROW
    }
}

constexpr int NPHASE = 15;
struct Args { const float* in[26]; float* out; unsigned char* ws; };
template <int LO, int HI> __global__ void __launch_bounds__(512, 2) mk_fwd(Args args) {
    extern __shared__ __attribute__((aligned(16))) unsigned char lds[];
    LAS unsigned char* L3 = (LAS unsigned char*)lds;
    volatile LAS unsigned* MISC = (volatile LAS unsigned*)(L3 + MISC_OFF);
    const int G = gridDim.x; const int bx = blockIdx.x; const int vcu = (G % 8 == 0) ? (bx % 8) * (G / 8) + bx / 8 : bx;
    const int NGW = G * 8;
    unsigned char* ws = args.ws; unsigned* ctl = (unsigned*)(ws + WS_CTL);
    { const int t0 = threadIdx.x;
      for (int u = t0; u < (LDS_BYTES - MISC_OFF) / 4; u += 512) MISC[u] = 0u;
      __syncthreads();
      if (t0 == 0) {
#pragma unroll
          for (int k = 0; k < 26; ++k) { const unsigned long long p = (unsigned long long)args.in[k]; MISC[64 + 2 * k] = (unsigned)p; MISC[65 + 2 * k] = (unsigned)(p >> 32); } }
      __syncthreads(); }
#ifdef PRB_PH
    if (PRB_PH2 == 0 && threadIdx.x == 0) MISC[11] = (unsigned)wall_clock64();
#endif
#define PH_IDS int tid = threadIdx.x; asm volatile("" : "+v"(tid) :: "memory"); const int lane = tid & 63, wave = __builtin_amdgcn_readfirstlane(tid >> 6), gw = vcu * 8 + wave; (void)lane; (void)gw;
#define INP(k) ((const float*)(((unsigned long long)(unsigned)__builtin_amdgcn_readfirstlane(MISCNV[65 + 2 * (k)]) << 32) | (unsigned long long)(unsigned)__builtin_amdgcn_readfirstlane(MISCNV[64 + 2 * (k)])))
#define PH_IN In I; I.x = INP(0); I.meta = INP(1); I.norm_mix = INP(2); I.w_in = INP(3); I.q_norm = INP(4); I.w_uq = INP(5); I.kv_norm = INP(6); I.w_ukv = INP(7); \
    I.conv_w = INP(8); I.conv_b = INP(9); I.dt_bias = INP(10); I.a_log = INP(11); I.d_skip = INP(12); I.ssm_norm = INP(13); I.w_ba = INP(14); I.w_bs = INP(15); \
    I.w_out = INP(16); I.norm_ffn = INP(17); I.w_group = INP(18); I.b_group = INP(19); I.w_expert = INP(20); I.b_expert = INP(21); I.w_gate = INP(22); I.w_up = INP(23); \
    I.w_down = INP(24); I.norm_final = INP(25);
    const LAS unsigned* MISCNV = (const LAS unsigned*)(L3 + MISC_OFF);
    XcdBarrier bar; bar.bar = ctl + CW_BAR + LO * XCD_BAR_WORDS; bar.x = 0; bar.st = nullptr;
    if (HI - LO > 1) bar = xcd_barrier_post(ctl + CW_BAR + LO * XCD_BAR_WORDS, MISC + 8);
#ifndef PH_MASK
#define PH_MASK 0x7fff
#endif
#define IN(k) (((PH_MASK >> (k)) & 1) && LO <= (k) && (k) < HI)
#ifdef PRB_PH
#define SEAM(k) do { if (LO <= (k) && (k) + 1 < HI) { if ((k) == PRB_PH && threadIdx.x == 0) MISC[10] += (unsigned)wall_clock64() - MISC[11]; xcd_barrier(bar); if ((k) + 1 == PRB_PH2 && threadIdx.x == 0) MISC[11] = (unsigned)wall_clock64(); } } while (0)
#elif defined(PRB_SLACK)
#define SEAM(k) do { if (LO <= (k) && (k) + 1 < HI) { const unsigned long long t0_ = wall_clock64(); xcd_barrier(bar); if (((PRB_SLACK >> (k)) & 1) && threadIdx.x == 0) MISC[10] += (unsigned)(wall_clock64() - t0_); } } while (0)
#else
#define SEAM(k) do { if (LO <= (k) && (k) + 1 < HI) xcd_barrier(bar); } while (0)
#endif

#define PH_PTRS unsigned char* wsp = ws; float* outp = args.out; asm volatile("" : "+s"(wsp), "+s"(outp)); \
bf16 *WinA = (bf16*)(wsp + WS_WINA), *WinB = (bf16*)(wsp + WS_WINB), *Wuq = (bf16*)(wsp + WS_WUQ), *Wukv = (bf16*)(wsp + WS_WUKV), *Wba = (bf16*)(wsp + WS_WBA), *Wbs = (bf16*)(wsp + WS_WBS), \
         *Wout = (bf16*)(wsp + WS_WOUT), *Wgu = (bf16*)(wsp + WS_WGU), *Wd = (bf16*)(wsp + WS_WD); \
    float* CS = (float*)(wsp + WS_CS); \
    bf16 *XN = (bf16*)(wsp + WS_XN), *KV = (bf16*)(wsp + WS_KV), *SA = (bf16*)(wsp + WS_SA), *SS = (bf16*)(wsp + WS_SS), *XBC = (bf16*)(wsp + WS_XBC), *MRG = (bf16*)(wsp + WS_MRG), *Y = (bf16*)(wsp + WS_Y), \
         *CQ = (bf16*)(wsp + WS_CQ), *CKV = (bf16*)(wsp + WS_CKV), *KR = (bf16*)(wsp + WS_KR), *VP = (bf16*)(wsp + WS_VP), *YP = (bf16*)(wsp + WS_YP), *HM = (bf16*)(wsp + WS_HM); \
    float *H1 = (float*)(wsp + WS_H1), *DT = (float*)(wsp + WS_DT), *SSQ = (float*)(wsp + WS_SSQ), *SSKV = (float*)(wsp + WS_SSKV), *TOKW = (float*)(wsp + WS_TOKW); \
    int* PROW = (int*)(wsp + WS_PROW); float* KRF = (float*)(wsp + WS_KRF); bf16 *ZB = (bf16*)(wsp + WS_Z), *DLB = (bf16*)(wsp + WS_DL); \
    bf16 *Qn = (bf16*)outp, *Qr = (bf16*)outp + (size_t)MROWS * 1024;
    if constexpr (IN(0)) { PH_PTRS PH_IDS PH_IN p0_prologue(I, ws, L3, gw, NGW, wave, lane); }
    SEAM(0);
    if constexpr (IN(1)) { PH_PTRS
        { pg8::Gemm g{XN, WinA, MROWS, 1792, 1024}; StdOrder S; S.init(MROWS, 1792, G, bx);
          EpiInA E{CQ, CKV, XBC, KRF, DT, SSQ, SSKV};
          pg8::gemm_phase<EpiInA, StdOrder, true, true>(L3, g, S, E); }
        { constexpr int UNITS = (MROWS / 256) * 7; const int rem = UNITS % G;
          if (bx >= rem) { PH_IDS PH_IN p0_items(I, ws, L3, P0_GU1, P0_GU3, (bx - rem) * 8 + wave, (G - rem) * 8, wave, lane); } }
    }
    SEAM(1);
    if constexpr (IN(2)) { PH_PTRS
        PH_IDS PH_IN
        p2_rowpass(KRF, KR, DT, CS, I.dt_bias, gw * 64 + lane, NGW * 64);
        pg8::Gemm g{CQ, Wuq, MROWS, 1536, 256}; TokOrder S; S.init(1536, G, bx); EpiQ E{Qn, Qr, SSQ, CS};
        pg8::gemm_phase<EpiQ, TokOrder, true, true>(L3, g, S, E);
    }
    if constexpr (LO <= 2 && 3 < HI) __syncthreads();
    if constexpr (IN(3)) { PH_PTRS
        { pg8::Gemm g{CKV, Wukv, MROWS, 2048, 128}; StdOrder S; S.init(MROWS, 2048, G, bx); EpiKV E{KV, SSKV};
          pg8::gemm_phase<EpiKV, StdOrder, true, true>(L3, g, S, E); }
        { constexpr int UNITS = (MROWS / 256) * 8; const int rem = UNITS % G;
          if (bx >= rem) { PH_IDS PH_IN p0_items(I, ws, L3, P0_GU3, P0_D0, (bx - rem) * 8 + wave, (G - rem) * 8, wave, lane); } }
    }
    SEAM(3);
    if constexpr (IN(4)) { PH_PTRS
        PH_IDS PH_IN
        constexpr int NSSD = NB * NHEAD / 2;
#ifndef NO_SSD
        for (int u = bx; u < NSSD; u += G) {
#ifdef PRB_SSDT
            const unsigned long long ts0_ = wall_clock64();
#endif
            ssd_unit(u >> 3, u & 7, I, XBC, DT, Y, L3, tid);
#ifdef PRB_SSDT
            if (threadIdx.x == 0) MISC[10] += (unsigned)(wall_clock64() - ts0_);
#endif
        }
#endif
#ifndef NO_ATT
        for (;;) {
            TU(0, L3);
            __syncthreads();
            if (tid == 0) MISC[1] = atomicAdd(ctl + CW_Q3 + 1, 1u);
            __syncthreads();
            TU(1, L3);
            const int a = (int)MISC[1];
            if (a >= 17 * 64) break;
            const int jb = 16 - a / 64, rem = a % 64; attn_unit(rem >> 3, rem & 7, jb, Qn, Qr, KV, KR, Qn, 0xffffffffu, L3, tid);
        }
#endif
        for (;;) {
            __syncthreads();
            if (tid == 0) MISC[2] = atomicAdd(ctl + CW_Q3 + 2, 1u);
            __syncthreads();
            const int q = 8 * (int)MISC[2] + wave;
            if (q - wave >= P0_Q_N) break;
            if (q < P0_Q_N) { const int it = q < 1536 ? 896 + q : 1216 + q; p0_items(I, ws, L3, it, it + 1, 0, 1, wave, lane); }
        }
    }
    SEAM(4);
    if constexpr (IN(5)) { PH_PTRS
        pg8::Gemm g{XN, WinB, MROWS, 3072, 1024}; TokOrder S; S.init(3072, G, bx); EpiZG E{ZB, SA, SS};
        pg8::gemm_phase<EpiZG, TokOrder, true, true>(L3, g, S, E);
    }
    SEAM(5);
    if constexpr (IN(6)) { PH_PTRS PH_IDS p5_groupnorm(Y, ZB, gw, NGW, lane); }
    SEAM(6);
    if constexpr (IN(7)) { PH_PTRS
        pg8::Gemm g{Qn, Wba, MROWS, 1024, 1024}; TokOrder S; S.init(1024, G, bx); EpiBr<0> E{MRG, SA};
        pg8::gemm_phase<EpiBr<0>, TokOrder, true, true>(L3, g, S, E);
    }
    if constexpr (LO <= 7 && 8 < HI) __syncthreads();
    if constexpr (IN(8)) { PH_PTRS
        pg8::Gemm g{Y, Wbs, MROWS, 1024, 1024}; TokOrder S; S.init(1024, G, bx); EpiBr<1> E{MRG, SS};
        pg8::gemm_phase<EpiBr<1>, TokOrder, true, true>(L3, g, S, E);
    }
    SEAM(8);
    if constexpr (IN(9)) { PH_PTRS
        pg8::Gemm g{MRG, Wout, MROWS, 1024, 1024}; TokOrder S; S.init(1024, G, bx); EpiOut E{DLB};
        pg8::gemm_phase<EpiOut, TokOrder, true, true>(L3, g, S, E);
    }
    SEAM(9);
    volatile LAS int* ost = (volatile LAS int*)(MISC + 16);
    if constexpr (IN(10)) { PH_PTRS PH_IDS PH_IN p10_router(I, ws, (float*)lds, (LAS unsigned*)(L3 + MISC_OFF) + 128, bx, gw, NGW, tid, lane); }
    SEAM(10);
    if constexpr (IN(11)) { PH_PTRS PH_IDS moe_bases(ws, ost, (volatile LAS int*)(MISC + 128), (volatile LAS int*)(MISC + 160), (volatile LAS int*)L3, bx, G, tid); p11_index(ws, ost, (volatile LAS int*)(MISC + 128), (volatile LAS int*)(MISC + 160), gw, NGW, lane); }
    SEAM(11);
    if constexpr (IN(12)) { PH_PTRS
        PH_IDS moe_offsets(ws, ost, (volatile LAS int*)(MISC + 128), tid);
        pg8::Gemm g{XN, Wgu, VPROWS, 16384, 1024}; MoeOrder S{(const LAS int*)ost, 2, G, bx}; EpiGU E{HM};
        pg8::gemm_phase<EpiGU, MoeOrder, true, true, true>(L3, g, S, E, (const int*)(wsp + WS_GIDX));
        { PH_IN const int rem = (2 * __builtin_amdgcn_readfirstlane(ost[NEXP] >> 8)) % G;
          if (bx >= rem) p0_items(I, ws, L3, P0_D0, P0_NIT, (bx - rem) * 8 + wave, (G - rem) * 8, wave, lane); }
    }
    SEAM(12);
    if constexpr (IN(13)) { PH_PTRS
        PH_IDS moe_offsets(ws, ost, (volatile LAS int*)(MISC + 128), tid);
        pg8::Gemm g{HM, Wd, VPROWS, 32768, 256}; MoeOrder S{(const LAS int*)ost, 4, G, bx}; EpiDown E{YP, PROW, TOKW};
        pg8::gemm_phase<EpiDown, MoeOrder, true, true>(L3, g, S, E);
    }
    SEAM(13);
#if defined(PRB_SLACK) || defined(PRB_PH)
    { if (threadIdx.x == 0) atomicAdd(ctl + 3000, MISC[10]); xcd_barrier(bar);
      const unsigned tot = xb_ld(ctl + 3000); const unsigned long long wait_ = (unsigned long long)tot * PRB_K / (unsigned)G; const unsigned long long ts_ = wall_clock64();
      while (wall_clock64() - ts_ < wait_) __builtin_amdgcn_s_sleep(8);
      __syncthreads(); }
#endif
    if constexpr (IN(14)) { PH_PTRS PH_IDS PH_IN const bool poison = __hip_atomic_load(bar.bar + XB_TMO, __ATOMIC_RELAXED, __HIP_MEMORY_SCOPE_AGENT) != 0u; p13_final(I, ws, args.out, gw, NGW, lane, poison); }
#undef IN
#undef SEAM
}

#ifndef MK_ONE_LAUNCH
#define MK_ONE_LAUNCH 1
#endif
template <int P> static void launch_phases(int grid, hipStream_t stream, const Args& a) {
    if constexpr (P < NPHASE) { hipLaunchKernelGGL((mk_fwd<P, P + 1>), dim3(grid), dim3(512), LDS_BYTES, stream, a); launch_phases<P + 1>(grid, stream, a); }
}
template <int P> static bool set_attr_phases() {
    if constexpr (P < NPHASE) { if (hipFuncSetAttribute((const void*)mk_fwd<P, P + 1>, hipFuncAttributeMaxDynamicSharedMemorySize, LDS_BYTES) != hipSuccess) return false; return set_attr_phases<P + 1>(); }
    else return true;
}
extern "C" void kernel_launch(void* const* d_in, const int* in_sizes, int n_in, void* d_out, int out_size, void* d_ws, size_t ws_size, hipStream_t stream) {
    static int grid = 0;
    if (grid == 0) {
        if (n_in != 26 || out_size != NB * SEQ * DM || ws_size < WS_END) { fprintf(stderr, "kernel_launch: unexpected problem (n_in %d, out %d, ws %zu); nothing launched\n", n_in, out_size, ws_size); grid = -1; return; }
        int dev = 0, cus = 0;
        if (hipGetDevice(&dev) != hipSuccess || hipDeviceGetAttribute(&cus, hipDeviceAttributeMultiprocessorCount, dev) != hipSuccess) { grid = -1; return; }
#if MK_ONE_LAUNCH
        if (hipFuncSetAttribute((const void*)mk_fwd<0, NPHASE>, hipFuncAttributeMaxDynamicSharedMemorySize, LDS_BYTES) != hipSuccess) { fprintf(stderr, "kernel_launch: hipFuncSetAttribute failed\n"); grid = -1; return; }
#else
        if (!set_attr_phases<0>()) { fprintf(stderr, "kernel_launch: hipFuncSetAttribute failed\n"); grid = -1; return; }
#endif
        (void)hipGetLastError();
        grid = cus;
    }
    if (grid < 0) return;
    (void)hipMemsetAsync((char*)d_ws + WS_CTL, 0, CTL_ZERO_BYTES, stream);
    Args a{};
    for (int i = 0; i < 26; ++i) a.in[i] = (const float*)d_in[i];
    a.out = (float*)d_out; a.ws = (unsigned char*)d_ws;
#if MK_ONE_LAUNCH
    hipLaunchKernelGGL((mk_fwd<0, NPHASE>), dim3(grid), dim3(512), LDS_BYTES, stream, a);
#else
    launch_phases<0>(grid, stream, a);
#endif
}
```
